# Optimizing an MI355X kernel written in HIP

```python
import jax, jax.numpy as jnp
from jax import lax
import numpy as np

D_MODEL = 2048
BATCH = 2
SEQ = 4096
DEPTH = 2

HEAD_DIM = 128
N_MLA_HEADS = 4
MLA_Q_LORA = 512
MLA_KV_LORA = 256
MLA_NOPE_DIM = 128
MLA_ROPE_DIM = 64
MLA_V_DIM = 128
N_MOBA_HEADS = 4
MOBA_BLOCK = 256
MOBA_TOPK = 3
MOBA_Q_CHUNK = 64
N_SWA_HEADS = 8
N_SWA_KV_HEADS = 2
SWA_WINDOW = 128
ATTN_Q_BLOCK = 128
D_FF = 5632
ROPE_THETA = 10000.0
NORM_EPS = 1e-6

MIX_WIDTH = N_MLA_HEADS * MLA_V_DIM + N_MOBA_HEADS * HEAD_DIM + N_SWA_HEADS * HEAD_DIM
IN_SIZES = (
    MLA_Q_LORA,
    MLA_KV_LORA,
    MLA_ROPE_DIM,
    N_MOBA_HEADS * HEAD_DIM,
    N_MOBA_HEADS * HEAD_DIM,
    N_MOBA_HEADS * HEAD_DIM,
    N_SWA_HEADS * HEAD_DIM,
    N_SWA_KV_HEADS * HEAD_DIM,
    N_SWA_KV_HEADS * HEAD_DIM,
)
IN_WIDTH = sum(IN_SIZES)

kernel_name = 'hymba_style_mla_moba_swa_macaron'


def rmsnorm(x, g):
    xf = x.astype(jnp.float32)
    y = xf * lax.rsqrt(jnp.mean(xf * xf, axis=-1, keepdims=True) + NORM_EPS)
    return (y * g.astype(jnp.float32)).astype(x.dtype)


def apply_rope(x, theta):
    S, d = x.shape[1], x.shape[-1]
    half = d // 2
    inv_freq = 1.0 / (theta ** (jnp.arange(half, dtype=jnp.float32) * (2.0 / d)))
    ang = jnp.arange(S, dtype=jnp.float32)[:, None] * inv_freq[None, :]
    cos = jnp.cos(ang)[None, :, None, :]
    sin = jnp.sin(ang)[None, :, None, :]
    xf = x.astype(jnp.float32)
    x1, x2 = xf[..., :half], xf[..., half:]
    return jnp.concatenate([x1 * cos - x2 * sin, x2 * cos + x1 * sin], axis=-1).astype(x.dtype)


def swiglu(x, w_gate, w_up, w_down):
    return (jax.nn.silu(x @ w_gate) * (x @ w_up)) @ w_down


def split_columns(z):
    cuts = np.cumsum(np.array(IN_SIZES))[:-1].tolist()
    return jnp.split(z, cuts, axis=-1)


def causal_attention_blocked(q, k, v, scale):
    B, S, H, dq = q.shape
    nb = S // ATTN_Q_BLOCK
    qb = q.reshape(B, nb, ATTN_Q_BLOCK, H, dq).transpose(1, 0, 2, 3, 4)
    kpos = jnp.arange(S)

    def one_block(args):
        qblk, i = args
        qpos = i * ATTN_Q_BLOCK + jnp.arange(ATTN_Q_BLOCK)
        s = jnp.einsum('bqhd,bkhd->bhqk', qblk, k).astype(jnp.float32) * scale
        s = jnp.where(kpos[None, :] <= qpos[:, None], s, -jnp.inf)
        p = jax.nn.softmax(s, axis=-1).astype(v.dtype)
        return jnp.einsum('bhqk,bkhd->bqhd', p, v)

    out = lax.map(one_block, (qb, jnp.arange(nb)))
    return out.transpose(1, 0, 2, 3, 4).reshape(B, S, H, v.shape[-1])


def mla_mixer(c_q, c_kv, k_rope, q_norm, w_uq, kv_norm, w_ukv):
    B, S, _ = c_q.shape
    H = N_MLA_HEADS
    q = (rmsnorm(c_q, q_norm) @ w_uq).reshape(B, S, H, MLA_NOPE_DIM + MLA_ROPE_DIM)
    q_nope, q_pe = q[..., :MLA_NOPE_DIM], q[..., MLA_NOPE_DIM:]
    q_pe = apply_rope(q_pe, ROPE_THETA)
    kv = (rmsnorm(c_kv, kv_norm) @ w_ukv).reshape(B, S, H, MLA_NOPE_DIM + MLA_V_DIM)
    k_nope, v = kv[..., :MLA_NOPE_DIM], kv[..., MLA_NOPE_DIM:]
    k_pe = apply_rope(k_rope[:, :, None, :], ROPE_THETA)
    k = jnp.concatenate([k_nope, jnp.broadcast_to(k_pe, (B, S, H, MLA_ROPE_DIM))], axis=-1)
    q = jnp.concatenate([q_nope, q_pe], axis=-1)
    o = causal_attention_blocked(q, k, v, (MLA_NOPE_DIM + MLA_ROPE_DIM) ** -0.5)
    return o.reshape(B, S, H * MLA_V_DIM)


def moba_attention(q, k, v):
    B, S, H, dh = q.shape
    Sp = -(-S // MOBA_BLOCK) * MOBA_BLOCK
    pad = Sp - S
    if pad:
        widths = ((0, 0), (0, pad), (0, 0), (0, 0))
        q, k, v = jnp.pad(q, widths), jnp.pad(k, widths), jnp.pad(v, widths)
    nkb = Sp // MOBA_BLOCK
    nqc = Sp // MOBA_Q_CHUNK
    top = min(MOBA_TOPK, nkb - 1)
    scale = dh ** -0.5
    kb = k.transpose(0, 2, 1, 3).reshape(B, H, nkb, MOBA_BLOCK, dh)
    vb = v.transpose(0, 2, 1, 3).reshape(B, H, nkb, MOBA_BLOCK, dh)
    kbar = jnp.mean(kb.astype(jnp.float32), axis=3).astype(k.dtype)
    qc = q.transpose(0, 2, 1, 3).reshape(B, H, nqc, MOBA_Q_CHUNK, dh).transpose(2, 0, 1, 3, 4)
    b_idx = jnp.arange(B)[:, None, None, None]
    h_idx = jnp.arange(H)[None, :, None, None]
    blk_ids = jnp.arange(nkb)

    def one_chunk(args):
        qblk, c = args
        qpos = c * MOBA_Q_CHUNK + jnp.arange(MOBA_Q_CHUNK)
        own = qpos[0] // MOBA_BLOCK
        k_own = lax.dynamic_index_in_dim(kb, own, axis=2, keepdims=False)
        v_own = lax.dynamic_index_in_dim(vb, own, axis=2, keepdims=False)
        s_own = jnp.einsum('bhqd,bhkd->bhqk', qblk, k_own).astype(jnp.float32) * scale
        kpos_own = own * MOBA_BLOCK + jnp.arange(MOBA_BLOCK)
        s_own = jnp.where(kpos_own[None, :] <= qpos[:, None], s_own, -jnp.inf)
        if top == 0:
            p = jax.nn.softmax(s_own, axis=-1).astype(v.dtype)
            return jnp.einsum('bhqk,bhkd->bhqd', p, v_own)
        gate = jnp.einsum('bhqd,bhnd->bhqn', qblk, kbar).astype(jnp.float32)
        gate = jnp.where(blk_ids < own, gate, -jnp.inf)
        _, sel = lax.top_k(gate, top)
        sel_valid = sel < own
        k_sel = kb[b_idx, h_idx, sel]
        v_sel = vb[b_idx, h_idx, sel]
        s_sel = jnp.einsum('bhqd,bhqjkd->bhqjk', qblk, k_sel).astype(jnp.float32) * scale
        s_sel = jnp.where(sel_valid[..., None], s_sel, -jnp.inf)
        s_sel = s_sel.reshape(B, H, MOBA_Q_CHUNK, top * MOBA_BLOCK)
        p = jax.nn.softmax(jnp.concatenate([s_sel, s_own], axis=-1), axis=-1).astype(v.dtype)
        p_sel = p[..., :top * MOBA_BLOCK].reshape(B, H, MOBA_Q_CHUNK, top, MOBA_BLOCK)
        p_own = p[..., top * MOBA_BLOCK:]
        return (jnp.einsum('bhqjk,bhqjkd->bhqd', p_sel, v_sel)
                + jnp.einsum('bhqk,bhkd->bhqd', p_own, v_own))

    out = lax.map(one_chunk, (qc, jnp.arange(nqc)))
    out = out.transpose(1, 0, 3, 2, 4).reshape(B, Sp, H * dh)
    return out[:, :S]


def swa_attention(q, k, v, sinks):
    B, S, Hq, dh = q.shape
    Hkv = k.shape[2]
    G = Hq // Hkv
    W = SWA_WINDOW
    nb = S // W
    scale = dh ** -0.5
    qb = q.reshape(B, nb, W, Hkv, G, dh)
    kb = k.reshape(B, nb, W, Hkv, dh)
    vb = v.reshape(B, nb, W, Hkv, dh)
    blk_pad = ((0, 0), (1, 0), (0, 0), (0, 0), (0, 0))
    kk = jnp.concatenate([jnp.pad(kb, blk_pad)[:, :-1], kb], axis=2)
    vv = jnp.concatenate([jnp.pad(vb, blk_pad)[:, :-1], vb], axis=2)
    s = jnp.einsum('bnqhgd,bnkhd->bhgnqk', qb, kk).astype(jnp.float32) * scale
    qpos = jnp.arange(nb)[:, None] * W + jnp.arange(W)[None, :]
    kpos = jnp.arange(nb)[:, None] * W - W + jnp.arange(2 * W)[None, :]
    rel = qpos[:, :, None] - kpos[:, None, :]
    mask = (rel >= 0) & (rel < W) & (kpos[:, None, :] >= 0)
    s = jnp.where(mask, s, -jnp.inf)
    sink = jnp.broadcast_to(sinks.astype(jnp.float32).reshape(1, Hkv, G, 1, 1, 1), s.shape[:-1] + (1,))
    p = jax.nn.softmax(jnp.concatenate([s, sink], axis=-1), axis=-1)[..., :-1].astype(v.dtype)
    o = jnp.einsum('bhgnqk,bnkhd->bnqhgd', p, vv)
    return o.reshape(B, S, Hq * dh)


def setup_inputs(seed: int = 0) -> dict:
    key = jax.random.key(seed)
    ks = jax.random.split(key, 24)
    L = DEPTH

    def normal(k, shape, fan_in):
        return jax.random.normal(k, shape, jnp.float32) * (fan_in ** -0.5)

    def gain(k, shape):
        return 1.0 + 0.01 * jax.random.normal(k, shape, jnp.float32)

    return {
        'x': jax.random.normal(ks[0], (BATCH, SEQ, D_MODEL), jnp.float32),
        'ffn1_norm': gain(ks[1], (L, D_MODEL)),
        'ffn1_w_gate': normal(ks[2], (L, D_MODEL, D_FF), D_MODEL),
        'ffn1_w_up': normal(ks[3], (L, D_MODEL, D_FF), D_MODEL),
        'ffn1_w_down': normal(ks[4], (L, D_FF, D_MODEL), D_FF),
        'attn_norm': gain(ks[5], (L, D_MODEL)),
        'w_in': normal(ks[6], (L, D_MODEL, IN_WIDTH), D_MODEL),
        'mla_q_norm': gain(ks[7], (L, MLA_Q_LORA)),
        'mla_w_uq': normal(ks[8], (L, MLA_Q_LORA, N_MLA_HEADS * (MLA_NOPE_DIM + MLA_ROPE_DIM)), MLA_Q_LORA),
        'mla_kv_norm': gain(ks[9], (L, MLA_KV_LORA)),
        'mla_w_ukv': normal(ks[10], (L, MLA_KV_LORA, N_MLA_HEADS * (MLA_NOPE_DIM + MLA_V_DIM)), MLA_KV_LORA),
        'swa_sinks': 0.5 * jax.random.normal(ks[11], (L, N_SWA_HEADS), jnp.float32),
        'w_out': normal(ks[12], (L, MIX_WIDTH, D_MODEL), MIX_WIDTH),
        'ffn2_norm': gain(ks[13], (L, D_MODEL)),
        'ffn2_w_gate': normal(ks[14], (L, D_MODEL, D_FF), D_MODEL),
        'ffn2_w_up': normal(ks[15], (L, D_MODEL, D_FF), D_MODEL),
        'ffn2_w_down': normal(ks[16], (L, D_FF, D_MODEL), D_FF),
        'final_norm': gain(ks[17], (D_MODEL,)),
    }


def reference(x, ffn1_norm, ffn1_w_gate, ffn1_w_up, ffn1_w_down, attn_norm, w_in,
              mla_q_norm, mla_w_uq, mla_kv_norm, mla_w_ukv, swa_sinks, w_out,
              ffn2_norm, ffn2_w_gate, ffn2_w_up, ffn2_w_down, final_norm):
    B, S, _ = x.shape
    for l in range(DEPTH):
        x = x + 0.5 * swiglu(rmsnorm(x, ffn1_norm[l]), ffn1_w_gate[l], ffn1_w_up[l], ffn1_w_down[l])

        h = rmsnorm(x, attn_norm[l])
        z = h @ w_in[l]
        c_q, c_kv, k_rope, mq, mk, mv, sq, sk, sv = split_columns(z)

        o_mla = mla_mixer(c_q, c_kv, k_rope, mla_q_norm[l], mla_w_uq[l], mla_kv_norm[l], mla_w_ukv[l])

        mq = apply_rope(mq.reshape(B, S, N_MOBA_HEADS, HEAD_DIM), ROPE_THETA)
        mk = apply_rope(mk.reshape(B, S, N_MOBA_HEADS, HEAD_DIM), ROPE_THETA)
        mv = mv.reshape(B, S, N_MOBA_HEADS, HEAD_DIM)
        o_moba = moba_attention(mq, mk, mv)

        sq = apply_rope(sq.reshape(B, S, N_SWA_HEADS, HEAD_DIM), ROPE_THETA)
        sk = apply_rope(sk.reshape(B, S, N_SWA_KV_HEADS, HEAD_DIM), ROPE_THETA)
        sv = sv.reshape(B, S, N_SWA_KV_HEADS, HEAD_DIM)
        o_swa = swa_attention(sq, sk, sv, swa_sinks[l])

        o = jnp.concatenate([o_mla, o_moba, o_swa], axis=-1)
        x = x + o @ w_out[l]

        x = x + 0.5 * swiglu(rmsnorm(x, ffn2_norm[l]), ffn2_w_gate[l], ffn2_w_up[l], ffn2_w_down[l])
    return rmsnorm(x, final_norm)
```

```cpp
#include <hip/hip_runtime.h>
#include <hip/hip_cooperative_groups.h>
#include <cstdio>
#include <cstdint>
namespace cg = cooperative_groups;
#ifndef DUP_MASK
#define DUP_MASK 0
#endif

typedef unsigned short bf16_t;
typedef short bf16x8 __attribute__((ext_vector_type(8)));
typedef float f32x4 __attribute__((ext_vector_type(4)));
typedef float f32x16 __attribute__((ext_vector_type(16)));
typedef unsigned u32x4 __attribute__((ext_vector_type(4)));
typedef unsigned u32x2 __attribute__((ext_vector_type(2)));

constexpr int T = 8192, SEQ = 4096, D = 2048, DFF = 5632, NGU = 2 * DFF, NIN = 4096  , ZW = 3904;
constexpr int NTHREADS = 512;
constexpr float EPS = 1e-6f;
constexpr float LOG2E = 1.4426950408889634f;

constexpr size_t SZ_GU = (size_t)NGU * D * 2, SZ_DN = (size_t)D * DFF * 2, SZ_IN = (size_t)NIN * D * 2, SZ_UQ = 768 * 512 * 2,
                 SZ_UKV = 1024 * 256 * 2, SZ_WO = (size_t)D * D * 2;
constexpr size_t LW_GU1 = 0, LW_D1 = LW_GU1 + SZ_GU, LW_IN = LW_D1 + SZ_DN, LW_UQ = LW_IN + SZ_IN, LW_UKV = LW_UQ + SZ_UQ,
                 LW_WO = LW_UKV + SZ_UKV, LW_GU2 = LW_WO + SZ_WO, LW_D2 = LW_GU2 + SZ_GU, LW_SIZE = LW_D2 + SZ_DN;
constexpr size_t OFF_XRES = 2 * LW_SIZE;
constexpr size_t OFF_XB = OFF_XRES + (size_t)T * D * 4;
constexpr size_t OFF_U = OFF_XB + (size_t)T * D * 2;
constexpr size_t OFF_CQN = OFF_U + (size_t)T * NIN * 4;
constexpr size_t OFF_CKVN = OFF_CQN + (size_t)T * 512 * 2;
constexpr size_t OFF_KPE = OFF_CKVN + (size_t)T * 256 * 2;
constexpr size_t OFF_MQ = OFF_KPE + (size_t)T * 64 * 2;
constexpr size_t OFF_MK = OFF_MQ + (size_t)T * 512 * 2;
constexpr size_t OFF_MV = OFF_MK + (size_t)T * 512 * 2;
constexpr size_t OFF_SQ = OFF_MV + (size_t)T * 512 * 2;
constexpr size_t OFF_SK = OFF_SQ + (size_t)T * 1024 * 2;
constexpr size_t OFF_SV = OFF_SK + (size_t)T * 256 * 2;
constexpr size_t OFF_KBAR = OFF_SV + (size_t)T * 256 * 2;
constexpr size_t OFF_QB = OFF_KBAR + 2 * 4 * 16 * 128 * 2;
constexpr size_t OFF_KVB = OFF_QB + (size_t)T * 768 * 2;
constexpr size_t OFF_OB = OFF_KVB + (size_t)T * 1024 * 2;
constexpr size_t OFF_SS = OFF_OB + (size_t)T * D * 2;
constexpr size_t OFF_R128 = OFF_SS + 11 * (size_t)T * 4;
constexpr size_t OFF_R64 = OFF_R128 + (size_t)SEQ * 64 * 2 * 4;
constexpr size_t OFF_CNT = OFF_R64 + (size_t)SEQ * 32 * 2 * 4;
constexpr size_t OFF_BAR = OFF_CNT + 256;
constexpr size_t OFF_KBARF = OFF_BAR + 3456 * 4;
constexpr size_t CTL_BYTES = 256 + 3456 * 4 + 2 * 16384 * 4;
constexpr size_t WS_NEED = OFF_CNT + CTL_BYTES;

struct Params {
    const float* x;
    const float* ffn1_norm; const float* ffn1_wg; const float* ffn1_wu; const float* ffn1_wd;
    const float* attn_norm; const float* w_in; const float* q_norm; const float* w_uq; const float* kv_norm; const float* w_ukv;
    const float* sinks; const float* w_out;
    const float* ffn2_norm; const float* ffn2_wg; const float* ffn2_wu; const float* ffn2_wd;
    const float* final_norm;
    float* out; char* ws;
};
typedef const __attribute__((address_space(4))) Params* PP;

__device__ __forceinline__ unsigned cvt_pk_bf16(float lo, float hi) { unsigned r; asm volatile("v_cvt_pk_bf16_f32 %0, %1, %2" : "=v"(r) : "v"(lo), "v"(hi)); return r; }
__device__ __forceinline__ bf16_t cvt_bf16(float v) { return (bf16_t)(cvt_pk_bf16(v, 0.f) & 0xffffu); }
__device__ __forceinline__ float bf16_lo(unsigned w) { return __uint_as_float(w << 16); }
__device__ __forceinline__ float bf16_hi(unsigned w) { return __uint_as_float(w & 0xffff0000u); }
__device__ __forceinline__ float fast_exp2(float x) { return __builtin_amdgcn_exp2f(x); }
__device__ __forceinline__ void sincos_rr(float ang, float& cs, float& sn) {
    const double rev = (double)ang * 0.15915494309189533577;
    const float fr = (float)(rev - floor(rev));
    sn = __builtin_amdgcn_sinf(fr); cs = __builtin_amdgcn_cosf(fr);
}


#define XB_TMO      128
#define XB_XCNT(j)  (256  + 64 * (j))
#define XB_XSUB(j)  (1280 + 64 * (j))
#define XB_XGEN(j)  (2304 + 64 * (j))
#define XB_TOP      3328
#define XB_TOPGEN   3392
#define XCD_BAR_WORDS 3456
#define XB_SPIN_CAP (1u << 18)
#define XLAS __attribute__((address_space(3)))
__device__ __forceinline__ unsigned xb_ld(unsigned* p)              { return __hip_atomic_load(p, __ATOMIC_RELAXED, __HIP_MEMORY_SCOPE_AGENT); }
__device__ __forceinline__ unsigned xb_add(unsigned* p, unsigned v) { return __hip_atomic_fetch_add(p, v, __ATOMIC_RELAXED, __HIP_MEMORY_SCOPE_AGENT); }
__device__ __forceinline__ unsigned xb_xcc_id() { return (unsigned)__builtin_amdgcn_s_getreg((3 << 11) | 20) & 0xFu; }
#define XB_SPIN(cond, bar) do { unsigned _sp = 0; while (cond) { __builtin_amdgcn_s_sleep(1); \
    if ((++_sp & 255u) == 0u) { if (xb_ld(&(bar)[XB_TMO])) break; if (_sp > XB_SPIN_CAP) { atomicAdd(&(bar)[XB_TMO], 1u); break; } } } } while (0)
struct XcdBarrier { unsigned* bar; unsigned x; volatile XLAS unsigned* st; };
__device__ __forceinline__ XcdBarrier xcd_barrier_post(unsigned* bar, volatile XLAS unsigned* st) {
    XcdBarrier b; b.bar = bar; b.x = xb_xcc_id(); b.st = st;
    if (threadIdx.x == 0) (void)xb_add(&bar[XB_XCNT(b.x)], 1u);
    return b;
}
__device__ __forceinline__ void xcd_barrier_complete(unsigned* bar, unsigned x, unsigned& nloc, unsigned& nx) {
    const unsigned G = gridDim.x * gridDim.y * gridDim.z;
    unsigned sum, cnt, mine, sp = 0u;
    for (;;) {
        sum = 0u; cnt = 0u; mine = 0u;
#pragma unroll
        for (unsigned j = 0; j < 16; ++j) { const unsigned c = xb_ld(&bar[XB_XCNT(j)]); sum += c; cnt += (c > 0u) ? 1u : 0u; mine = (j == x) ? c : mine; }
        if (sum == G) break;
        __builtin_amdgcn_s_sleep(1);
        if ((++sp & 255u) == 0u) { if (xb_ld(&bar[XB_TMO])) break; if (sp > XB_SPIN_CAP) { atomicAdd(&bar[XB_TMO], 1u); break; } }
    }
    nloc = mine > 0u ? mine : 1u; nx = cnt > 0u ? cnt : 1u;
}
__device__ __forceinline__ void xcd_barrier(const XcdBarrier& b) {
    asm volatile("s_waitcnt vmcnt(0)" ::: "memory");
    __syncthreads();
    if (threadIdx.x == 0) {
        unsigned* bar = b.bar;
        __builtin_amdgcn_s_waitcnt(0);
        unsigned nloc = b.st[0], nx = b.st[1];
        if (nloc == 0u) { xcd_barrier_complete(bar, b.x, nloc, nx); b.st[0] = nloc; b.st[1] = nx; }
        const unsigned old = xb_add(&bar[XB_XSUB(b.x)], 1u);
        const unsigned gen = old / nloc;
        if (old + 1u == (gen + 1u) * nloc) {
            __builtin_amdgcn_fence(__ATOMIC_RELEASE, "agent");
            asm volatile("s_waitcnt vmcnt(0)" ::: "memory");
            const unsigned og = xb_add(&bar[XB_TOP], 1u);
            const unsigned tg = og / nx;
            if (og + 1u == (tg + 1u) * nx) xb_add(&bar[XB_TOPGEN], 1u);
            else XB_SPIN(xb_ld(&bar[XB_TOPGEN]) == tg, bar);
            __builtin_amdgcn_fence(__ATOMIC_ACQUIRE, "agent");
            xb_add(&bar[XB_XGEN(b.x)], 1u);
            asm volatile("s_waitcnt vmcnt(0)" ::: "memory");
        } else {
            XB_SPIN(xb_ld(&bar[XB_XGEN(b.x)]) == gen, bar);
            __builtin_amdgcn_fence(__ATOMIC_ACQUIRE, "agent");
            asm volatile("s_waitcnt vmcnt(0)" ::: "memory");
        }
    }
    __syncthreads();
}

constexpr int BM = 256, BK = 64, HALF = 128, NXCD = 8, WGM = 4, HT = HALF * BK;
constexpr int GEMM_LDS = 8 * HT * 2;

__device__ __forceinline__ int lds_byte(int r, int c) {
    int st = (r >> 4) * 2 + (c >> 5), rr = r & 15, cc = c & 31, ob = rr * 64 + cc * 2;
    return st * 1024 + (ob ^ (((ob >> 9) & 1) << 5));
}
__device__ __forceinline__ void stage_rc(int b, int& R, int& C) {
    int st = b / 1024, sb = b % 1024, swz = sb ^ (((sb >> 9) & 1) << 5);
    R = (st >> 1) * 16 + swz / 64; C = (st & 1) * 32 + (swz % 64) / 2;
}

#define LAS __attribute__((address_space(3)))
struct Unit { int pm, pn; };
__device__ __forceinline__ void tile_order(int L, int nM, int nN, int& pm, int& pn) {
    const int nwg = nM * nN; int wgid = L;
    { const int q = nwg / NXCD, r = nwg % NXCD, xcd = wgid % NXCD, off = wgid / NXCD; wgid = (xcd < r ? xcd * (q + 1) : r * (q + 1) + (xcd - r) * q) + off; }
    const int nig = WGM * nN, gid = wgid / nig, fm = gid * WGM, gsz = (nM - fm) < WGM ? (nM - fm) : WGM;
    pm = fm + ((wgid % nig) % gsz); pn = (wgid % nig) / gsz;
}
__device__ __forceinline__ bool unit_next(int i, int G, int c, int nM, int nN, Unit& u) {
    const long L = (long)i * G + c; if (c < 0 || L >= (long)nM * nN) return false;
    tile_order((int)L, nM, nN, u.pm, u.pn); return true;
}

constexpr int HTB = HALF * BK * 2;
template <class Epi>
__device__ __forceinline__ void gemm_run(LAS unsigned char* lds, const bf16_t* gA, const bf16_t* gBt, const int nM, const int nN, const int K, const int G, const int c, const Epi& E, const int tid_) {
    const int tid = tid_, wid = __builtin_amdgcn_readfirstlane(tid >> 6), lane = tid & 63, wr = wid >> 2, wc = wid & 3, fr = lane & 15, fq = lane >> 4;
    const int nt = K / BK;
    unsigned voffA[2];
#pragma unroll
    for (int i = 0; i < 2; ++i) { int R, C; stage_rc(tid * 16 + i * 8192, R, C); voffA[i] = (unsigned)(R * K + C) * 2u; }
    const size_t kstep = (size_t)(BK * 2);
    const size_t hstep = (size_t)HALF * K * 2;
    const size_t tstep = 2 * hstep;
    const unsigned ldsw = (unsigned)wid * 1024u;
    const int aoff = lds_byte(wr * 64 + fr, fq * 8), boff = lds_byte(wc * 32 + fr, fq * 8);
#define PG8_SA(b, h) (((b) * 2 + (h)) * HTB)
#define PG8_SB(b, h) ((4 + (b) * 2 + (h)) * HTB)
#define PG8_STAGE(bufoff, gbase) do { _Pragma("unroll") for (int _i = 0; _i < 2; ++_i) \
        __builtin_amdgcn_global_load_lds((const unsigned*)((const char*)(gbase) + voffA[_i]), (LAS unsigned*)(lds + (bufoff) + ldsw + _i * 8192), 16, 0, 0); } while (0)
#define PG8_LDA(dst, b, h) do { _Pragma("unroll") for (int m = 0; m < 4; ++m) _Pragma("unroll") for (int k = 0; k < 2; ++k) dst[m][k] = *(const LAS bf16x8*)(lds + PG8_SA(b, h) + aoff + m * 2048 + k * 1024); } while (0)
#define PG8_LDB(dst, b, h) do { _Pragma("unroll") for (int n = 0; n < 2; ++n) _Pragma("unroll") for (int k = 0; k < 2; ++k) dst[n][k] = *(const LAS bf16x8*)(lds + PG8_SB(b, h) + boff + n * 2048 + k * 1024); } while (0)
#define PG8_MMA(ai, bj, At, Bt) do { __builtin_amdgcn_s_setprio(1); _Pragma("unroll") for (int m = 0; m < 4; ++m) _Pragma("unroll") for (int n = 0; n < 2; ++n) _Pragma("unroll") for (int k = 0; k < 2; ++k) \
        acc[ai][bj][m][n] = __builtin_amdgcn_mfma_f32_16x16x32_bf16(Bt[n][k], At[m][k], acc[ai][bj][m][n], 0, 0, 0); __builtin_amdgcn_s_setprio(0); } while (0)
#define PG8_WAIT_V(n) asm volatile("s_waitcnt vmcnt(" #n ")" ::: "memory")
#define PG8_WAIT_L(n) asm volatile("s_waitcnt lgkmcnt(" #n ")" ::: "memory")
#define PG8_BAR __builtin_amdgcn_s_barrier()
#define PG8_SCHED __builtin_amdgcn_sched_barrier(0)
    Unit cur, nxt; int ui = 0;
    if (!unit_next(0, G, c, nM, nN, cur)) return;
    f32x4 acc[2][2][4][2];
#pragma unroll
    for (int a = 0; a < 2; ++a)
#pragma unroll
        for (int b = 0; b < 2; ++b)
#pragma unroll
            for (int m = 0; m < 4; ++m)
#pragma unroll
                for (int n = 0; n < 2; ++n) acc[a][b][m][n] = (f32x4){0.f, 0.f, 0.f, 0.f};
    bf16x8 At[4][2], B0[2][2], B1[2][2];
    const char* cA = (const char*)gA + (size_t)cur.pm * tstep; const char* cB = (const char*)gBt + (size_t)cur.pn * tstep;
    PG8_STAGE(PG8_SB(0, 0), cB); PG8_STAGE(PG8_SB(0, 1), cB + hstep); PG8_STAGE(PG8_SA(0, 0), cA); PG8_STAGE(PG8_SA(0, 1), cA + hstep);
    PG8_STAGE(PG8_SB(1, 0), cB + kstep); PG8_STAGE(PG8_SA(1, 0), cA + kstep); PG8_STAGE(PG8_SB(1, 1), cB + hstep + kstep);
    if (wr == 1) PG8_BAR;
    PG8_WAIT_V(8); PG8_BAR;
    PG8_WAIT_V(6); PG8_BAR;
    for (;;) {
        const bool has_next = unit_next(ui + 1, G, c, nM, nN, nxt);
        const char* nA = has_next ? (const char*)gA + (size_t)nxt.pm * tstep : cA; const char* nB = has_next ? (const char*)gBt + (size_t)nxt.pn * tstep : cB;
#pragma unroll 1
        for (int t = 0; t < nt; t += 2) {
            const bool last = (t == nt - 2);
            const char* a1 = cA + (size_t)(t + 1) * kstep;
            const char* a2 = last ? nA : cA + (size_t)(t + 2) * kstep; const char* b2 = last ? nB : cB + (size_t)(t + 2) * kstep;
            const char* a3 = a2 + kstep; const char* b3 = b2 + kstep;
            PG8_LDB(B0, 0, 0); PG8_LDB(B1, 0, 1); PG8_SCHED; PG8_LDA(At, 0, 0); PG8_STAGE(PG8_SA(1, 1), a1 + hstep);
            PG8_WAIT_V(8); PG8_WAIT_L(0); PG8_BAR; PG8_MMA(0, 0, At, B0); PG8_MMA(0, 1, At, B1); PG8_BAR; PG8_SCHED;
            PG8_LDA(At, 0, 1); PG8_STAGE(PG8_SB(0, 0), b2); PG8_STAGE(PG8_SB(0, 1), b2 + hstep); PG8_STAGE(PG8_SA(0, 0), a2);
            PG8_WAIT_V(8); PG8_WAIT_L(0); PG8_BAR; PG8_MMA(1, 0, At, B0); PG8_MMA(1, 1, At, B1); PG8_BAR; PG8_SCHED;
            PG8_LDB(B0, 1, 0); PG8_LDB(B1, 1, 1); PG8_SCHED; PG8_LDA(At, 1, 0); PG8_STAGE(PG8_SA(0, 1), a2 + hstep);
            PG8_WAIT_V(8); PG8_WAIT_L(0); PG8_BAR; PG8_MMA(0, 0, At, B0); PG8_MMA(0, 1, At, B1); PG8_BAR; PG8_SCHED;
            PG8_LDA(At, 1, 1); PG8_STAGE(PG8_SB(1, 0), b3); PG8_STAGE(PG8_SB(1, 1), b3 + hstep); PG8_STAGE(PG8_SA(1, 0), a3);
            PG8_WAIT_V(8); PG8_WAIT_L(0); PG8_BAR; PG8_MMA(1, 0, At, B0); PG8_MMA(1, 1, At, B1); PG8_BAR; PG8_SCHED;
        }
        if (wr == 0) PG8_BAR;
        E(acc, cur.pm * BM, cur.pn * BM, wr, wc, fr, fq);
        if (!has_next) break;
#pragma unroll
        for (int a = 0; a < 2; ++a)
#pragma unroll
            for (int b = 0; b < 2; ++b)
#pragma unroll
                for (int m = 0; m < 4; ++m)
#pragma unroll
                    for (int n = 0; n < 2; ++n) acc[a][b][m][n] = (f32x4){0.f, 0.f, 0.f, 0.f};
        cur = nxt; cA = nA; cB = nB; ++ui;
        if (wr == 1) PG8_BAR;
    }
    PG8_WAIT_V(0);
    PG8_BAR;
#undef PG8_SA
#undef PG8_SB
#undef PG8_STAGE
#undef PG8_LDA
#undef PG8_LDB
#undef PG8_MMA
}

struct GemmDesc {
    const bf16_t* A; const bf16_t* Bt; int nN; int K; int epi;
    const float* ssin; const float* xin; float* outf; bf16_t* outb; float* ssout; float scale; int ld; char* ws; int layer;
};
template <bool KB>
__device__ __forceinline__ void epi_rope128(const f32x4 (&acc)[2][2][4][2], const float* ssin, char* ws, bf16_t* dst, int ld, int dcol, int layer, int pn,
                                            int brow, int wr, int wc, int fr, int fq) {
                const float* r128 = (const float*)(ws + OFF_R128);
                const int hsel = wc >> 1, fb = (wc & 1) * 32 + fq * 4;
                f32x4 ks1[2], ks2[2];
#pragma unroll
                for (int n = 0; n < 2; ++n) { ks1[n] = (f32x4){0.f, 0.f, 0.f, 0.f}; ks2[n] = (f32x4){0.f, 0.f, 0.f, 0.f}; }
                float rs[8];
#pragma unroll
                for (int i8 = 0; i8 < 8; ++i8) rs[i8] = ssin[brow + (i8 >> 2) * HALF + wr * 64 + (i8 & 3) * 16 + fr];
                f32x4 tb[2][2][2];
                {
                    const int pos0 = (brow + wr * 64 + fr) & (SEQ - 1);
#pragma unroll
                    for (int n = 0; n < 2; ++n) { const float* tp = r128 + ((size_t)pos0 * 64 + fb + n * 16) * 2; tb[0][n][0] = *(const f32x4*)tp; tb[0][n][1] = *(const f32x4*)(tp + 4); }
                }
#pragma unroll
                for (int ai = 0; ai < 2; ++ai)
#pragma unroll
                    for (int m = 0; m < 4; ++m) {
                        const int it8 = ai * 4 + m, cur = it8 & 1;
                        const int row = brow + ai * HALF + wr * 64 + m * 16 + fr;
                        if (it8 < 7) {
                            const int nrow = brow + ((it8 + 1) >> 2) * HALF + wr * 64 + ((it8 + 1) & 3) * 16 + fr, npos = nrow & (SEQ - 1);
#pragma unroll
                            for (int n = 0; n < 2; ++n) { const float* tp = r128 + ((size_t)npos * 64 + fb + n * 16) * 2; tb[cur ^ 1][n][0] = *(const f32x4*)tp; tb[cur ^ 1][n][1] = *(const f32x4*)(tp + 4); }
                        }
                        const float r = rsqrtf(rs[it8] * (1.0f / D) + EPS);
#pragma unroll
                        for (int n = 0; n < 2; ++n) {
                            const int f0 = fb + n * 16;
                            const f32x4 ca = tb[cur][n][0], cb = tb[cur][n][1];
                            const f32x4 x1 = acc[ai][0][m][n] * r, x2 = acc[ai][1][m][n] * r;
                            f32x4 o1, o2;
                            o1[0] = x1[0] * ca[0] - x2[0] * ca[1]; o2[0] = x2[0] * ca[0] + x1[0] * ca[1];
                            o1[1] = x1[1] * ca[2] - x2[1] * ca[3]; o2[1] = x2[1] * ca[2] + x1[1] * ca[3];
                            o1[2] = x1[2] * cb[0] - x2[2] * cb[1]; o2[2] = x2[2] * cb[0] + x1[2] * cb[1];
                            o1[3] = x1[3] * cb[2] - x2[3] * cb[3]; o2[3] = x2[3] * cb[2] + x1[3] * cb[3];
                            u32x2 w1, w2; w1.x = cvt_pk_bf16(o1[0], o1[1]); w1.y = cvt_pk_bf16(o1[2], o1[3]); w2.x = cvt_pk_bf16(o2[0], o2[1]); w2.y = cvt_pk_bf16(o2[2], o2[3]);
                            bf16_t* op = dst + (size_t)row * ld + dcol + hsel * 128 + f0;
                            *(u32x2*)op = w1; *(u32x2*)(op + 64) = w2;
                            if (KB) { ks1[n] += o1; ks2[n] += o2;
                                asm volatile("" : "+v"(ks1[n][0]), "+v"(ks1[n][1]), "+v"(ks1[n][2]), "+v"(ks1[n][3]), "+v"(ks2[n][0]), "+v"(ks2[n][1]), "+v"(ks2[n][2]), "+v"(ks2[n][3])); }
                        }
                        __builtin_amdgcn_sched_barrier(0);
                    }
                if (KB) {
                    float* kb = (float*)(ws + OFF_KBARF) + (size_t)layer * 16384 + ((size_t)((brow >> 12) * 4 + (pn - 5) * 2 + hsel) * 16 + ((brow & (SEQ - 1)) >> 8)) * 128;
#pragma unroll
                    for (int n = 0; n < 2; ++n)
#pragma unroll
                        for (int j = 0; j < 4; ++j) {
                            float a = ks1[n][j], b2 = ks2[n][j];
#pragma unroll
                            for (int o = 1; o < 16; o <<= 1) { a += __shfl_xor(a, o); b2 += __shfl_xor(b2, o); }
                            if (fr == 0) { atomicAdd(kb + fb + n * 16 + j, a); atomicAdd(kb + 64 + fb + n * 16 + j, b2); }
                        }
                }
}

struct EpiRt {
    const GemmDesc& d;
    __device__ __forceinline__ void operator()(const f32x4 (&acc)[2][2][4][2], int brow, int bcol, int wr, int wc, int fr, int fq) const {
        asm volatile("" : "+s"(brow), "+s"(bcol), "+s"(wr), "+s"(wc));
        asm volatile("" : "+v"(fr), "+v"(fq));
        if (d.epi == 0) {
            const int cbase = (bcol >> 1) + wc * 32 + fq * 8;
            float rs[8];
#pragma unroll
            for (int i8 = 0; i8 < 8; ++i8) rs[i8] = d.ssin[brow + (i8 >> 2) * HALF + wr * 64 + (i8 & 3) * 16 + fr];
#pragma unroll
            for (int ai = 0; ai < 2; ++ai)
#pragma unroll
                for (int m = 0; m < 4; ++m) {
                    const int row = brow + ai * HALF + wr * 64 + m * 16 + fr;
                    const float r = rsqrtf(rs[ai * 4 + m] * (1.0f / D) + EPS);
                    u32x4 w;
#pragma unroll
                    for (int bj = 0; bj < 2; ++bj) {
                        const f32x4 g = acc[ai][bj][m][0] * r, u = acc[ai][bj][m][1] * r;
                        float a[4];
#pragma unroll
                        for (int j = 0; j < 4; ++j) a[j] = g[j] * u[j] * __builtin_amdgcn_rcpf(1.0f + fast_exp2(g[j] * -LOG2E));
                        if (bj == 0) { w.x = cvt_pk_bf16(a[0], a[1]); w.y = cvt_pk_bf16(a[2], a[3]); } else { w.z = cvt_pk_bf16(a[0], a[1]); w.w = cvt_pk_bf16(a[2], a[3]); }
                    }
                    *(u32x4*)(d.outb + (size_t)row * DFF + cbase) = w;
                }
        } else if (d.epi == 1) {
#pragma unroll
            for (int ai = 0; ai < 2; ++ai) {
                f32x4 xo[4][2][2];
#pragma unroll
                for (int m = 0; m < 4; ++m) {
                    const int row = brow + ai * HALF + wr * 64 + m * 16 + fr;
#pragma unroll
                    for (int bj = 0; bj < 2; ++bj)
#pragma unroll
                        for (int n = 0; n < 2; ++n)
                            xo[m][bj][n] = *(const f32x4*)(d.xin + (size_t)row * D + bcol + bj * HALF + wc * 32 + n * 16 + fq * 4);
                }
                float sqv[4];
#pragma unroll
                for (int m = 0; m < 4; ++m) {
                    const int row = brow + ai * HALF + wr * 64 + m * 16 + fr;
                    float sq = 0.f;
#pragma unroll
                    for (int bj = 0; bj < 2; ++bj)
#pragma unroll
                        for (int n = 0; n < 2; ++n) {
                            const size_t o = (size_t)row * D + bcol + bj * HALF + wc * 32 + n * 16 + fq * 4;
                            const f32x4 xn = xo[m][bj][n] + acc[ai][bj][m][n] * d.scale;
                            *(f32x4*)(d.outf + o) = xn;
                            u32x2 w; w.x = cvt_pk_bf16(xn[0], xn[1]); w.y = cvt_pk_bf16(xn[2], xn[3]);
                            *(u32x2*)(d.outb + o) = w;
                            sq += xn[0] * xn[0] + xn[1] * xn[1] + xn[2] * xn[2] + xn[3] * xn[3];
                        }
                    sq += __shfl_xor(sq, 16); sq += __shfl_xor(sq, 32);
                    sqv[m] = sq;
                }
                if (fq == 0) {
#pragma unroll
                    for (int m = 0; m < 4; ++m) atomicAdd(d.ssout + brow + ai * HALF + wr * 64 + m * 16 + fr, sqv[m]);
                }
            }
        } else if (d.epi == 2) {
            const int pn = bcol >> 8;
            char* ws = d.ws;
            int kind, dcol = 0, ld = 0; bf16_t* dst; float* ssx = nullptr; bool iskb = false;
            if (pn < 2)        { kind = 0; dst = (bf16_t*)(ws + OFF_CQN);  ld = 512;  dcol = pn * 256; ssx = (float*)(ws + OFF_SS) + (7 + 2 * d.layer) * T; }
            else if (pn == 2)  { kind = 0; dst = (bf16_t*)(ws + OFF_CKVN); ld = 256;  ssx = (float*)(ws + OFF_SS) + (8 + 2 * d.layer) * T; }
            else if (pn < 5)   { kind = 1; dst = (bf16_t*)(ws + OFF_MQ);   ld = 512;  dcol = (pn - 3) * 256; }
            else if (pn < 7)   { kind = 1; dst = (bf16_t*)(ws + OFF_MK);   ld = 512;  dcol = (pn - 5) * 256; iskb = true; }
            else if (pn < 9)   { kind = 2; dst = (bf16_t*)(ws + OFF_MV);   ld = 512;  dcol = (pn - 7) * 256; }
            else if (pn < 13)  { kind = 1; dst = (bf16_t*)(ws + OFF_SQ);   ld = 1024; dcol = (pn - 9) * 256; }
            else if (pn == 13) { kind = 1; dst = (bf16_t*)(ws + OFF_SK);   ld = 256; }
            else if (pn == 14) { kind = 2; dst = (bf16_t*)(ws + OFF_SV);   ld = 256; }
            else               { kind = 3; dst = (bf16_t*)(ws + OFF_KPE);  ld = 64; }
            if (kind == 0 || kind == 2) {
#pragma unroll
                for (int ai = 0; ai < 2; ++ai)
#pragma unroll
                    for (int m = 0; m < 4; ++m) {
                        const int row = brow + ai * HALF + wr * 64 + m * 16 + fr;
                        const float r = rsqrtf(d.ssin[row] * (1.0f / D) + EPS);
                        float sq = 0.f;
#pragma unroll
                        for (int bj = 0; bj < 2; ++bj)
#pragma unroll
                            for (int n = 0; n < 2; ++n) {
                                const f32x4 v = acc[ai][bj][m][n] * r;
                                u32x2 w; w.x = cvt_pk_bf16(v[0], v[1]); w.y = cvt_pk_bf16(v[2], v[3]);
                                *(u32x2*)(dst + (size_t)row * ld + dcol + bj * HALF + wc * 32 + n * 16 + fq * 4) = w;
                                sq += v[0] * v[0] + v[1] * v[1] + v[2] * v[2] + v[3] * v[3];
                            }
                        if (kind == 0) { sq += __shfl_xor(sq, 16); sq += __shfl_xor(sq, 32); if (fq == 0) atomicAdd(ssx + row, sq); }
                    }
            } else if (kind == 1) {
                if (iskb) epi_rope128<true>(acc, d.ssin, ws, dst, ld, dcol, d.layer, pn, brow, wr, wc, fr, fq);
                else epi_rope128<false>(acc, d.ssin, ws, dst, ld, dcol, d.layer, pn, brow, wr, wc, fr, fq);
            } else {
                const float* r64 = (const float*)(ws + OFF_R64);
                if (wc == 0) {
#pragma unroll
                    for (int ai = 0; ai < 2; ++ai)
#pragma unroll
                        for (int m = 0; m < 4; ++m) {
                            const int row = brow + ai * HALF + wr * 64 + m * 16 + fr, pos = row & (SEQ - 1);
                            const float r = rsqrtf(d.ssin[row] * (1.0f / D) + EPS);
#pragma unroll
                            for (int n = 0; n < 2; ++n) {
                                const int f0 = n * 16 + fq * 4;
                                const f32x4 ca = *(const f32x4*)(r64 + ((size_t)pos * 32 + f0) * 2), cb = *(const f32x4*)(r64 + ((size_t)pos * 32 + f0) * 2 + 4);
                                const f32x4 x1 = acc[ai][0][m][n] * r, x2 = acc[ai][1][m][n] * r;
                                f32x4 o1, o2;
                                o1[0] = x1[0] * ca[0] - x2[0] * ca[1]; o2[0] = x2[0] * ca[0] + x1[0] * ca[1];
                                o1[1] = x1[1] * ca[2] - x2[1] * ca[3]; o2[1] = x2[1] * ca[2] + x1[1] * ca[3];
                                o1[2] = x1[2] * cb[0] - x2[2] * cb[1]; o2[2] = x2[2] * cb[0] + x1[2] * cb[1];
                                o1[3] = x1[3] * cb[2] - x2[3] * cb[3]; o2[3] = x2[3] * cb[2] + x1[3] * cb[3];
                                u32x2 w1, w2; w1.x = cvt_pk_bf16(o1[0], o1[1]); w1.y = cvt_pk_bf16(o1[2], o1[3]); w2.x = cvt_pk_bf16(o2[0], o2[1]); w2.y = cvt_pk_bf16(o2[2], o2[3]);
                                bf16_t* op = dst + (size_t)row * 64 + f0;
                                *(u32x2*)op = w1; *(u32x2*)(op + 32) = w2;
                            }
                        }
                }
            }
        } else {
#pragma unroll
            for (int ai = 0; ai < 2; ++ai)
#pragma unroll
                for (int m = 0; m < 4; ++m) {
                    const int row = brow + ai * HALF + wr * 64 + m * 16 + fr;
                    const float r = rsqrtf(d.ssin[row] * d.scale + EPS);
#pragma unroll
                    for (int bj = 0; bj < 2; ++bj)
#pragma unroll
                        for (int n = 0; n < 2; ++n) {
                            const f32x4 v = acc[ai][bj][m][n] * r;
                            u32x2 w; w.x = cvt_pk_bf16(v[0], v[1]); w.y = cvt_pk_bf16(v[2], v[3]);
                            *(u32x2*)(d.outb + (size_t)row * d.ld + bcol + bj * HALF + wc * 32 + n * 16 + fq * 4) = w;
                        }
                }
        }
    }
};

struct ColPlain { const float* W; int ncols; __device__ __forceinline__ const float* operator()(int n) const { return n < ncols ? W + n : nullptr; } };
struct ColGateUp { const float* Wg; const float* Wu;
    __device__ __forceinline__ const float* operator()(int n) const {
        const int pn = n >> 8, p = n & 255, bj = p >> 7, wc = (p >> 5) & 3, nn = (p >> 4) & 1, q4 = p & 15;
        const int col = pn * 128 + wc * 32 + (q4 >> 2) * 8 + bj * 4 + (q4 & 3);
        const uintptr_t a = (uintptr_t)Wg, b = (uintptr_t)Wu;
        return (const float*)(a ^ ((a ^ b) & (uintptr_t)0 - (uintptr_t)nn)) + col;
    } };

__device__ __forceinline__ int win_col(int n) {
    const int tile = n >> 8, p = n & 255, bj = p >> 7, q = p & 127;
    const int rope = (q >> 6) * 128 + (q & 63) + 64 * bj;
    if (tile < 3) return n;
    if (tile < 5) return 832 + (tile - 3) * 256 + rope;
    if (tile < 7) return 1344 + (tile - 5) * 256 + rope;
    if (tile < 9) return 1856 + (tile - 7) * 256 + p;
    if (tile < 13) return 2368 + (tile - 9) * 256 + rope;
    if (tile == 13) return 3392 + rope;
    if (tile == 14) return 3648 + p;
    return q < 32 ? 768 + q + 32 * bj : -1;
}
struct CvtItem { const float* src; const float* gain; bf16_t* dst; int ldw, K, n0, k0; };
__device__ __forceinline__ void cvt_decode(PP p, int it, int n4, CvtItem& c) {
    constexpr int I_GU = (NGU / 64) * (D / 256), I_DN = (D / 64) * (DFF / 256), I_IN = (NIN / 64) * (D / 256), I_UQ = (768 / 64) * (512 / 256),
                  I_UKV = (1024 / 64) * (256 / 256), I_WO = (D / 64) * (D / 256);
    constexpr int C0 = I_GU, C1 = C0 + I_DN, C2 = C1 + I_IN, C3 = C2 + I_UQ, C4 = C3 + I_UKV, C5 = C4 + I_WO, C6 = C5 + I_GU, C7 = C6 + I_DN;
    const int l = it / C7; int r = it - l * C7;
    char* lw = p->ws + (size_t)l * LW_SIZE;
    c.gain = nullptr;
    if (r < C0 || (r >= C5 && r < C6)) {
        const bool second = r >= C5; if (second) r -= C5;
        const int nb = r % (NGU / 64), kb = r / (NGU / 64);
        ColGateUp cm{(second ? p->ffn2_wg : p->ffn1_wg) + (size_t)l * D * DFF, (second ? p->ffn2_wu : p->ffn1_wu) + (size_t)l * D * DFF};
        c.src = cm(nb * 64 + n4); c.ldw = DFF; c.gain = (second ? p->ffn2_norm : p->ffn1_norm) + l * D; c.dst = (bf16_t*)(lw + (second ? LW_GU2 : LW_GU1)); c.K = D; c.n0 = nb * 64; c.k0 = kb * 256;
    } else if (r < C1 || r >= C6) {
        const bool second = r >= C6; r -= second ? C6 : C0;
        const int nb = r % (D / 64), kb = r / (D / 64);
        c.src = (second ? p->ffn2_wd : p->ffn1_wd) + (size_t)l * DFF * D + nb * 64 + n4; c.ldw = D; c.dst = (bf16_t*)(lw + (second ? LW_D2 : LW_D1)); c.K = DFF; c.n0 = nb * 64; c.k0 = kb * 256;
    } else if (r < C2) {
        r -= C1; const int nb = r % (NIN / 64), kb = r / (NIN / 64);
        const int n = nb * 64 + n4;
        const int col = win_col(n);
        c.src = col >= 0 ? p->w_in + (size_t)l * D * ZW + col : nullptr; c.ldw = ZW; c.gain = p->attn_norm + l * D; c.dst = (bf16_t*)(lw + LW_IN); c.K = D; c.n0 = nb * 64; c.k0 = kb * 256;
    } else if (r < C3) {
        r -= C2; const int nb = r % (768 / 64), kb = r / (768 / 64);
        c.src = p->w_uq + (size_t)l * 512 * 768 + nb * 64 + n4; c.ldw = 768; c.gain = p->q_norm + l * 512; c.dst = (bf16_t*)(lw + LW_UQ); c.K = 512; c.n0 = nb * 64; c.k0 = kb * 256;
    } else if (r < C4) {
        r -= C3; const int nb = r % (1024 / 64), kb = r / (1024 / 64);
        c.src = p->w_ukv + (size_t)l * 256 * 1024 + nb * 64 + n4; c.ldw = 1024; c.gain = p->kv_norm + l * 256; c.dst = (bf16_t*)(lw + LW_UKV); c.K = 256; c.n0 = nb * 64; c.k0 = kb * 256;
    } else {
        r -= C4; const int nb = r % (D / 64), kb = r / (D / 64);
        c.src = p->w_out + (size_t)l * D * D + nb * 64 + n4; c.ldw = D; c.dst = (bf16_t*)(lw + LW_WO); c.K = D; c.n0 = nb * 64; c.k0 = kb * 256;
    }
}
constexpr int CVT_ITEMS = 2 * (2 * ((NGU / 64) * (D / 256)) + 2 * ((D / 64) * (DFF / 256)) + (NIN / 64) * (D / 256) + (768 / 64) * 2 + (1024 / 64) + (D / 64) * (D / 256));

#define CVT_LOAD(S, c_) do { _Pragma("unroll") for (int i = 0; i < 8; ++i) v##S[i] = (c_).src ? __builtin_nontemporal_load((const f32x4*)((c_).src + (size_t)((c_).k0 + kq + 32 * i) * (c_).ldw)) : (f32x4){0.f, 0.f, 0.f, 0.f}; } while (0)
#define CVT_EMIT(S, c_) do { \
        _Pragma("unroll") for (int i = 0; i < 8; ++i) { const int kl = kq + 32 * i; const float g = (c_).gain ? (c_).gain[(c_).k0 + kl] : 1.f; \
            float* tp = tile + kl * 65 + n4; tp[0] = v##S[i][0] * g; tp[1] = v##S[i][1] * g; tp[2] = v##S[i][2] * g; tp[3] = v##S[i][3] * g; } \
        __syncthreads(); \
        bf16_t* dst = (c_).dst; const int K = (c_).K, n0 = (c_).n0, k0 = (c_).k0; \
        if (itn < hi) { cvt_decode(p, itn, n4, (c_)); CVT_LOAD(S, c_); } \
        { const int kc_lo = t & 7, nl = t >> 3; \
          _Pragma("unroll") for (int i = 0; i < 4; ++i) { const int k8 = (kc_lo + 8 * i) * 8; float w[8]; \
            _Pragma("unroll") for (int j = 0; j < 8; ++j) w[j] = tile[(k8 + j) * 65 + nl]; \
            u32x4 o; o.x = cvt_pk_bf16(w[0], w[1]); o.y = cvt_pk_bf16(w[2], w[3]); o.z = cvt_pk_bf16(w[4], w[5]); o.w = cvt_pk_bf16(w[6], w[7]); \
            *(u32x4*)(dst + (size_t)(n0 + nl) * K + k0 + k8) = o; } } \
        __syncthreads(); } while (0)
__device__ __forceinline__ void cvt_range(PP p, float* tile, const int tid_, const int lo, const int hi, const int first, const int stride) {
    const int t = tid_, n4 = (t & 15) * 4, kq = t >> 4;
    f32x4 vA[8], vB[8];
    CvtItem cA, cB;
    int it = lo + first;
    if (it < hi) { cvt_decode(p, it, n4, cA); CVT_LOAD(A, cA); }
    if (it + stride < hi) { cvt_decode(p, it + stride, n4, cB); CVT_LOAD(B, cB); }
#pragma unroll 1
    for (; it < hi; it += 2 * stride) {
        { const int itn = it + 2 * stride; CVT_EMIT(A, cA); }
        if (it + stride < hi) { const int itn = it + 3 * stride; CVT_EMIT(B, cB); }
    }
}
#undef CVT_LOAD
#undef CVT_EMIT
__shared__ uint4 ctl_words;
constexpr int CVT_CH = 2;
__device__ __forceinline__ void cvt_dyn(PP p, float* tile, const int tid_, const int lo, const int hi, unsigned* ctr) {
    volatile XLAS unsigned* s_chunk_p = (volatile XLAS unsigned*)&ctl_words + 3;
    for (;;) {
        if (tid_ == 0) *s_chunk_p = atomicAdd(ctr, (unsigned)CVT_CH);
        __syncthreads();
        const int base = lo + (int)*s_chunk_p;
        __syncthreads();
        if (base >= hi) break;
        cvt_range(p, tile, tid_, base, base + CVT_CH < hi ? base + CVT_CH : hi, 0, 1);
    }
}

constexpr int NCONV = 16;
constexpr int CV_L = CVT_ITEMS / 2;
constexpr int CV_CG = 2400, CV_CA = 1400;
constexpr int cv_max(int a, int b) { return a > b ? a : b; }
constexpr int CV_E15 = CVT_ITEMS;
constexpr int CV_E13 = CVT_ITEMS - (D / 64) * (DFF / 256);
constexpr int CV_D_UQKV1 = CV_L + 2664, CV_D_GU1_1 = CV_L + 1408, CV_D_GU2_0 = 4328, CV_D_UQKV0 = 2664;
constexpr int CV_E9 = cv_max(CV_D_UQKV1, CV_E13 - CV_CA);
constexpr int CV_E7 = cv_max(CV_D_GU1_1, CV_E9 - CV_CG);
constexpr int CV_E5 = cv_max(CV_D_GU2_0, CV_E7 - CV_CG);
constexpr int CV_E1 = cv_max(CV_D_UQKV0, CV_E5 - CV_CA);
constexpr int CV_P0 = cv_max(1408, CV_E1 - CV_CG);
static_assert(CV_L == 5032 && CV_E13 - CV_E9 >= 0 && CV_E15 - CV_E13 == 704, "conversion schedule");

__device__ __forceinline__ void prep_phase(PP p, float* tile, const int tid_) {
    int tid_x = tid_; asm volatile("" : "+v"(tid_x));
    const int wid = tid_x >> 6, lane = tid_x & 63;
    float* ss = (float*)(p->ws + OFF_SS);
    bf16_t* xb = (bf16_t*)(p->ws + OFF_XB);
    for (int row = blockIdx.x * 8 + wid; row < T; row += gridDim.x * 16) {
        const int row2 = row + gridDim.x * 8;
        const bool has2 = row2 < T;
        f32x4 va[8], vb[8];
#pragma unroll
        for (int i = 0; i < 8; ++i) va[i] = *(const f32x4*)(p->x + (size_t)row * D + i * 256 + lane * 4);
#pragma unroll
        for (int i = 0; i < 8; ++i) vb[i] = has2 ? *(const f32x4*)(p->x + (size_t)row2 * D + i * 256 + lane * 4) : (f32x4){0.f, 0.f, 0.f, 0.f};
        float s = 0.f, s2 = 0.f;
#pragma unroll
        for (int i = 0; i < 8; ++i) {
            const f32x4 v = va[i];
            s += v[0] * v[0] + v[1] * v[1] + v[2] * v[2] + v[3] * v[3];
            u32x2 w; w.x = cvt_pk_bf16(v[0], v[1]); w.y = cvt_pk_bf16(v[2], v[3]);
            *(u32x2*)(xb + (size_t)row * D + i * 256 + lane * 4) = w;
        }
        if (has2) {
#pragma unroll
            for (int i = 0; i < 8; ++i) {
                const f32x4 v = vb[i];
                s2 += v[0] * v[0] + v[1] * v[1] + v[2] * v[2] + v[3] * v[3];
                u32x2 w; w.x = cvt_pk_bf16(v[0], v[1]); w.y = cvt_pk_bf16(v[2], v[3]);
                *(u32x2*)(xb + (size_t)row2 * D + i * 256 + lane * 4) = w;
            }
        }
#pragma unroll
        for (int o = 1; o < 64; o <<= 1) { s += __shfl_xor(s, o); s2 += __shfl_xor(s2, o); }
        if (lane == 0) { ss[row] = s; if (has2) ss[row2] = s2; }
    }
    for (int i = blockIdx.x * NTHREADS + tid_; i < 10 * T; i += gridDim.x * NTHREADS) ss[T + i] = 0.f;
    float* r128 = (float*)(p->ws + OFF_R128); float* r64 = (float*)(p->ws + OFF_R64);
    for (int i = blockIdx.x * NTHREADS + tid_; i < SEQ * 64; i += gridDim.x * NTHREADS) {
        const int pos = i >> 6, f = i & 63;
        const float inv = 1.0f / powf(10000.0f, (float)f * (2.0f / 128.0f));
        const float ang = (float)pos * inv;
        float cs, sn; sincos_rr(ang, cs, sn);
        r128[2 * i] = cs; r128[2 * i + 1] = sn;
    }
    for (int i = blockIdx.x * NTHREADS + tid_; i < SEQ * 32; i += gridDim.x * NTHREADS) {
        const int pos = i >> 5, f = i & 31;
        const float inv = 1.0f / powf(10000.0f, (float)f * (2.0f / 64.0f));
        const float ang = (float)pos * inv;
        float cs, sn; sincos_rr(ang, cs, sn);
        r64[2 * i] = cs; r64[2 * i + 1] = sn;
    }
}

__device__ __forceinline__ void post_phase(PP p, int layer, float* red, const int tid_) {
    const float* z = (const float*)(p->ws + OFF_U);
    const float* r128 = (const float*)(p->ws + OFF_R128); const float* r64 = (const float*)(p->ws + OFF_R64);
    bf16_t* cqn = (bf16_t*)(p->ws + OFF_CQN); bf16_t* ckvn = (bf16_t*)(p->ws + OFF_CKVN); bf16_t* kpe = (bf16_t*)(p->ws + OFF_KPE);
    bf16_t* mq = (bf16_t*)(p->ws + OFF_MQ); bf16_t* mk = (bf16_t*)(p->ws + OFF_MK); bf16_t* mv = (bf16_t*)(p->ws + OFF_MV);
    bf16_t* sq = (bf16_t*)(p->ws + OFF_SQ); bf16_t* sk = (bf16_t*)(p->ws + OFF_SK); bf16_t* sv = (bf16_t*)(p->ws + OFF_SV);
    bf16_t* kbar = (bf16_t*)(p->ws + OFF_KBAR);
    const int wid = tid_ >> 6, lane = tid_ & 63;
    constexpr int NU = 27;
    for (int it = blockIdx.x; it < 32 * NU; it += gridDim.x) {
        const int tb = it / NU, u = it % NU;
        const int row0 = tb * 256 + wid * 32;
        if (u == 0) {
            const float* g = p->q_norm + layer * 512;
            const f32x4 g0 = *(const f32x4*)(g + lane * 4), g1 = *(const f32x4*)(g + 256 + lane * 4);
            for (int rr = 0; rr < 32; ++rr) {
                const int row = row0 + rr; const float* zr = z + (size_t)row * NIN;
                const f32x4 a = *(const f32x4*)(zr + lane * 4), b = *(const f32x4*)(zr + 256 + lane * 4);
                float s = a[0] * a[0] + a[1] * a[1] + a[2] * a[2] + a[3] * a[3] + b[0] * b[0] + b[1] * b[1] + b[2] * b[2] + b[3] * b[3];
#pragma unroll
                for (int o = 1; o < 64; o <<= 1) s += __shfl_xor(s, o);
                const float r = rsqrtf(s * (1.0f / 512.0f) + EPS);
                u32x2 w0, w1;
                w0.x = cvt_pk_bf16(a[0] * r * g0[0], a[1] * r * g0[1]); w0.y = cvt_pk_bf16(a[2] * r * g0[2], a[3] * r * g0[3]);
                w1.x = cvt_pk_bf16(b[0] * r * g1[0], b[1] * r * g1[1]); w1.y = cvt_pk_bf16(b[2] * r * g1[2], b[3] * r * g1[3]);
                *(u32x2*)(cqn + (size_t)row * 512 + lane * 4) = w0; *(u32x2*)(cqn + (size_t)row * 512 + 256 + lane * 4) = w1;
            }
        } else if (u == 1) {
            const f32x4 g0 = *(const f32x4*)(p->kv_norm + layer * 256 + lane * 4);
            for (int rr = 0; rr < 32; ++rr) {
                const int row = row0 + rr; const float* zr = z + (size_t)row * NIN + 512;
                const f32x4 a = *(const f32x4*)(zr + lane * 4);
                float s = a[0] * a[0] + a[1] * a[1] + a[2] * a[2] + a[3] * a[3];
#pragma unroll
                for (int o = 1; o < 64; o <<= 1) s += __shfl_xor(s, o);
                const float r = rsqrtf(s * (1.0f / 256.0f) + EPS);
                u32x2 w0; w0.x = cvt_pk_bf16(a[0] * r * g0[0], a[1] * r * g0[1]); w0.y = cvt_pk_bf16(a[2] * r * g0[2], a[3] * r * g0[3]);
                *(u32x2*)(ckvn + (size_t)row * 256 + lane * 4) = w0;
            }
        } else if (u == 2) {
            for (int rr = 0; rr < 32; ++rr) {
                const int row = row0 + rr, pos = row & (SEQ - 1); const float* zr = z + (size_t)row * NIN + 768;
                const int f = lane & 31;
                const float x1 = zr[f], x2 = zr[f + 32];
                const float c = r64[(pos * 32 + f) * 2], s = r64[(pos * 32 + f) * 2 + 1];
                const float o = (lane < 32) ? (x1 * c - x2 * s) : (x2 * c + x1 * s);
                kpe[(size_t)row * 64 + lane] = cvt_bf16(o);
            }
        } else {
            int zc; bf16_t* dst; int ld; int dc; bool rope = true; bool isk = false; int hk = 0;
            if (u < 7) { const int h = u - 3; zc = 832 + h * 128; dst = mq; ld = 512; dc = h * 128; }
            else if (u < 11) { const int h = u - 7; zc = 1344 + h * 128; dst = mk; ld = 512; dc = h * 128; isk = true; hk = h; }
            else if (u < 15) { const int h = u - 11; zc = 1856 + h * 128; dst = mv; ld = 512; dc = h * 128; rope = false; }
            else if (u < 23) { const int h = u - 15; zc = 2368 + h * 128; dst = sq; ld = 1024; dc = h * 128; }
            else if (u < 25) { const int h = u - 23; zc = 3392 + h * 128; dst = sk; ld = 256; dc = h * 128; }
            else { const int h = u - 25; zc = 3648 + h * 128; dst = sv; ld = 256; dc = h * 128; rope = false; }
            float a1 = 0.f, a2 = 0.f;
            for (int rr = 0; rr < 32; ++rr) {
                const int row = row0 + rr, pos = row & (SEQ - 1); const float* zr = z + (size_t)row * NIN + zc;
                const float x1 = zr[lane], x2 = zr[lane + 64];
                float o1 = x1, o2 = x2;
                if (rope) {
                    const float c = r128[(pos * 64 + lane) * 2], s = r128[(pos * 64 + lane) * 2 + 1];
                    o1 = x1 * c - x2 * s; o2 = x2 * c + x1 * s;
                }
                a1 += o1; a2 += o2;
                dst[(size_t)row * ld + dc + lane] = cvt_bf16(o1); dst[(size_t)row * ld + dc + 64 + lane] = cvt_bf16(o2);
            }
            if (isk) {
                red[wid * 128 + lane] = a1; red[wid * 128 + 64 + lane] = a2;
                __syncthreads();
                if (tid_ < 128) {
                    float s = 0.f;
#pragma unroll
                    for (int w = 0; w < 8; ++w) s += red[w * 128 + tid_];
                    const int b = tb >> 4, n = tb & 15;
                    kbar[((size_t)(b * 4 + hk) * 16 + n) * 128 + tid_] = cvt_bf16(s * (1.0f / 256.0f));
                }
                __syncthreads();
            }
        }
    }
}

template <int DQ, int TYPE>
__device__ __forceinline__ void attn_item(PP p, int layer, int b, int h, int qt, char* lds, const int tid_, unsigned* next_ctr, volatile XLAS unsigned* slot) {
    constexpr int KLD = DQ + 8, NKS = DQ / 16, KBYTES = 64 * KLD * 2, VLD = 68, STAGE = KBYTES + 128 * VLD * 2;
    const int t = tid_, wid = __builtin_amdgcn_readfirstlane(t >> 6), lane = t & 63, r = lane & 31, hh = lane >> 5, qg = wid & 3, kh = wid >> 2;
    const size_t tok0 = (size_t)b * SEQ;
    const bf16_t *Qp, *Kp, *Vp, *Kpe = nullptr; int ldq, ldk, ldv; bf16_t* Op; float scale;
    if (TYPE == 0) {
        Qp = (const bf16_t*)(p->ws + OFF_QB) + tok0 * 768 + h * 192; ldq = 768;
        Kp = (const bf16_t*)(p->ws + OFF_KVB) + tok0 * 1024 + h * 256; ldk = 1024;
        Vp = Kp + 128; ldv = 1024;
        Kpe = (const bf16_t*)(p->ws + OFF_KPE) + tok0 * 64;
        Op = (bf16_t*)(p->ws + OFF_OB) + tok0 * D + h * 128; scale = 0.07216878364870322f;
    } else if (TYPE == 1) {
        Qp = (const bf16_t*)(p->ws + OFF_MQ) + tok0 * 512 + h * 128; ldq = 512;
        Kp = (const bf16_t*)(p->ws + OFF_MK) + tok0 * 512 + h * 128; ldk = 512;
        Vp = (const bf16_t*)(p->ws + OFF_MV) + tok0 * 512 + h * 128; ldv = 512;
        Op = (bf16_t*)(p->ws + OFF_OB) + tok0 * D + 512 + h * 128; scale = 0.08838834764831845f;
    } else {
        Qp = (const bf16_t*)(p->ws + OFF_SQ) + tok0 * 1024 + h * 128; ldq = 1024;
        Kp = (const bf16_t*)(p->ws + OFF_SK) + tok0 * 256 + (h >> 2) * 128; ldk = 256;
        Vp = (const bf16_t*)(p->ws + OFF_SV) + tok0 * 256 + (h >> 2) * 128; ldv = 256;
        Op = (bf16_t*)(p->ws + OFF_OB) + tok0 * D + 1024 + h * 128; scale = 0.08838834764831845f;
    }
    const float c = scale * LOG2E;
    const int j_hi = 2 * qt + 1, j_lo = (TYPE == 2) ? (qt > 0 ? 2 * qt - 2 : 0) : 0;
    const int own = qt >> 1;
    const int qpos = 128 * qt + 32 * qg + r;

    u32x4 kregA[DQ == 192 ? 3 : 2], vregA[2];
    const int dg = t & 15, kp = t >> 4;
#define A_GLOAD(S, j_) do { const size_t k0_ = (size_t)(j_) * 64; \
        _Pragma("unroll") for (int i = 0; i < 2; ++i) { const int id = t + 512 * i, row = id >> 4, ch = id & 15; kreg##S[i] = *(const u32x4*)(Kp + (k0_ + row) * ldk + ch * 8); } \
        if (TYPE == 0) { const int row = t >> 3, ch = t & 7; kreg##S[DQ == 192 ? 2 : 0] = *(const u32x4*)(Kpe + (k0_ + row) * 64 + ch * 8); } \
        _Pragma("unroll") for (int i = 0; i < 2; ++i) vreg##S[i] = *(const u32x4*)(Vp + (k0_ + 2 * kp + i) * ldv + dg * 8); } while (0)
#define A_LSTORE(S, buf_) do { bf16_t* Ks_ = (bf16_t*)(lds + (buf_) * STAGE); bf16_t* Vt_ = (bf16_t*)(lds + (buf_) * STAGE + KBYTES); \
        _Pragma("unroll") for (int i = 0; i < 2; ++i) { const int id = t + 512 * i, row = id >> 4, ch = id & 15; *(u32x4*)(Ks_ + row * KLD + ch * 8) = kreg##S[i]; } \
        if (TYPE == 0) { const int row = t >> 3, ch = t & 7; *(u32x4*)(Ks_ + row * KLD + 128 + ch * 8) = kreg##S[DQ == 192 ? 2 : 0]; } \
        _Pragma("unroll") for (int w = 0; w < 4; ++w) { const unsigned a0 = vreg##S[0][w], a1 = vreg##S[1][w]; \
            *(unsigned*)(Vt_ + (dg * 8 + 2 * w) * VLD + 2 * kp) = (a0 & 0xffffu) | (a1 << 16); \
            *(unsigned*)(Vt_ + (dg * 8 + 2 * w + 1) * VLD + 2 * kp) = (a0 >> 16) | (a1 & 0xffff0000u); } } while (0)

    A_GLOAD(A, j_lo);
    bf16x8 qf[NKS];
    {
        const bf16_t* qrow = Qp + (size_t)qpos * ldq + 8 * hh;
#pragma unroll
        for (int ks = 0; ks < NKS; ++ks) qf[ks] = *(const bf16x8*)(qrow + 16 * ks);
        if (TYPE == 0) {
            const float* r64 = (const float*)(p->ws + OFF_R64) + (size_t)qpos * 64;
#pragma unroll
            for (int kk = 0; kk < 2; ++kk) {
                bf16x8 x1 = qf[8 + kk], x2 = qf[10 + kk], o1, o2;
#pragma unroll
                for (int j = 0; j < 8; ++j) {
                    const int f = 16 * kk + 8 * hh + j;
                    const float cs = r64[2 * f], sn = r64[2 * f + 1];
                    const float a = __uint_as_float(((unsigned)(unsigned short)x1[j]) << 16), bb = __uint_as_float(((unsigned)(unsigned short)x2[j]) << 16);
                    o1[j] = (short)cvt_bf16(a * cs - bb * sn); o2[j] = (short)cvt_bf16(bb * cs + a * sn);
                }
                qf[8 + kk] = o1; qf[10 + kk] = o2;
            }
        }
    }
    unsigned qmask = 0;
    if (TYPE == 1) {
        if (own > 0) {
            const float* kb = (const float*)(p->ws + OFF_KBARF) + (size_t)layer * 16384 + (size_t)(b * 4 + h) * 16 * 128;
            f32x16 g = {};
#pragma unroll
            for (int ks = 0; ks < 8; ++ks) {
                bf16x8 a = {};
                if (r < 16) {
                    const f32x4 k0v = *(const f32x4*)(kb + r * 128 + 16 * ks + 8 * hh), k1v = *(const f32x4*)(kb + r * 128 + 16 * ks + 8 * hh + 4);
                    u32x4 pk; pk.x = cvt_pk_bf16(k0v[0] * (1.0f / 256.0f), k0v[1] * (1.0f / 256.0f)); pk.y = cvt_pk_bf16(k0v[2] * (1.0f / 256.0f), k0v[3] * (1.0f / 256.0f));
                    pk.z = cvt_pk_bf16(k1v[0] * (1.0f / 256.0f), k1v[1] * (1.0f / 256.0f)); pk.w = cvt_pk_bf16(k1v[2] * (1.0f / 256.0f), k1v[3] * (1.0f / 256.0f));
                    a = __builtin_bit_cast(bf16x8, pk);
                }
                g = __builtin_amdgcn_mfma_f32_32x32x16_bf16(a, qf[ks], g, 0, 0, 0);
            }
            float mine[8], theirs[8];
#pragma unroll
            for (int i = 0; i < 8; ++i) { mine[i] = g[i]; theirs[i] = __shfl_xor(g[i], 32); }
            unsigned bits = 0;
#pragma unroll
            for (int i = 0; i < 8; ++i) {
                const int n = 8 * (i >> 2) + 4 * hh + (i & 3);
                int rank = 0;
#pragma unroll
                for (int i2 = 0; i2 < 8; ++i2) {
                    const int n1 = 8 * (i2 >> 2) + 4 * hh + (i2 & 3), n2 = 8 * (i2 >> 2) + 4 * (1 - hh) + (i2 & 3);
                    if (n1 < own && (mine[i2] > mine[i] || (mine[i2] == mine[i] && n1 < n))) ++rank;
                    if (n2 < own && (theirs[i2] > mine[i] || (theirs[i2] == mine[i] && n2 < n))) ++rank;
                }
                if (n < own && rank < 3) bits |= 1u << n;
            }
            qmask = bits | (unsigned)__shfl_xor((int)bits, 32);
        }
    }

    f32x16 O[4];
#pragma unroll
    for (int md = 0; md < 4; ++md)
#pragma unroll
        for (int i = 0; i < 16; ++i) O[md][i] = 0.f;
    float m_run = -1e30f, l_run = 0.f;
    if (TYPE == 2 && kh == 0) { m_run = p->sinks[layer * 8 + h] * LOG2E; l_run = (hh == 0) ? 1.f : 0.f; }
    constexpr int GK = (DQ == 192) ? 3 : 4, NG = NKS / GK;

    A_LSTORE(A, 0); __syncthreads();
    if (kh == 0) __builtin_amdgcn_s_setprio(2);
#pragma unroll 1
    for (int j = j_lo; j <= j_hi; ++j) {
        const int buf = (j - j_lo) & 1;
        if (j < j_hi) A_GLOAD(A, j + 1);
        int mode = 0;
        if (TYPE == 2) mode = 2;
        else if (TYPE == 1 && (j >> 2) < own) mode = 3;
        else if (j >= 2 * qt) mode = 1;
        const int kbase_pos = 64 * j + 32 * kh;
        const int qlo = 128 * qt + 32 * qg;
        bool skip = false;
        if (mode == 1 || mode == 2) { if (kbase_pos > qlo + 31) skip = true; }
        if (mode == 2) { if (kbase_pos + 31 <= qlo - 128) skip = true; }
        if (!skip) {
            const bf16_t* Ks = (const bf16_t*)(lds + buf * STAGE); const bf16_t* Vt = (const bf16_t*)(lds + buf * STAGE + KBYTES);
            f32x16 sacc;
#pragma unroll
            for (int i = 0; i < 16; ++i) sacc[i] = 0.f;
            const bf16_t* kb_ = Ks + (32 * kh + r) * KLD + 8 * hh;
            bf16x8 kf[2][GK];
#pragma unroll
            for (int i = 0; i < GK; ++i) kf[0][i] = *(const bf16x8*)(kb_ + 16 * i);
#pragma unroll
            for (int g = 0; g < NG; ++g) {
                if (g + 1 < NG) {
#pragma unroll
                    for (int i = 0; i < GK; ++i) kf[(g + 1) & 1][i] = *(const bf16x8*)(kb_ + 16 * ((g + 1) * GK + i));
                }
                __builtin_amdgcn_sched_barrier(0);
#pragma unroll
                for (int i = 0; i < GK; ++i) sacc = __builtin_amdgcn_mfma_f32_32x32x16_bf16(kf[g & 1][i], qf[g * GK + i], sacc, 0, 0, 0);
                __builtin_amdgcn_sched_barrier(0);
            }
            const bf16_t* vb0 = Vt + r * VLD + 32 * kh + 4 * hh;
            u32x2 vf[2][4][2];
#pragma unroll
            for (int md = 0; md < 4; ++md) { vf[0][md][0] = *(const u32x2*)(vb0 + md * 32 * VLD); vf[0][md][1] = *(const u32x2*)(vb0 + md * 32 * VLD + 8); }
            if (mode != 0) {
                const bool selbit = (qmask >> (j >> 2)) & 1u;
#pragma unroll
                for (int i = 0; i < 16; ++i) {
                    const int kpos = kbase_pos + 8 * (i >> 2) + 4 * hh + (i & 3);
                    const int dd = qpos - kpos;
                    bool ok;
                    if (mode == 1) ok = dd >= 0; else if (mode == 2) ok = (dd >= 0 && dd < 128); else ok = selbit;
                    if (!ok) sacc[i] = -INFINITY;
                }
            }
            float mx = fmaxf(sacc[0], sacc[1]);
#pragma unroll
            for (int i = 2; i < 16; i += 2) mx = fmaxf(mx, fmaxf(sacc[i], sacc[i + 1]));
            mx *= c;
            mx = fmaxf(mx, __shfl_xor(mx, 32));
            const float m_old_ = m_run;
            const float mnew = fmaxf(m_run, mx);
            const float alpha = fast_exp2(m_run - mnew);
            m_run = mnew;
            float ls = 0.f;
#pragma unroll
            for (int i = 0; i < 16; ++i) { sacc[i] = fast_exp2(__builtin_fmaf(sacc[i], c, -mnew)); ls += sacc[i]; }
            l_run = l_run * alpha + ls;
            if (__builtin_amdgcn_ballot_w64(mx > m_old_) != 0) {
#pragma unroll
                for (int md = 0; md < 4; ++md) O[md] *= alpha;
            }
#pragma unroll
            for (int s2 = 0; s2 < 2; ++s2) {
                if (s2 == 0) {
#pragma unroll
                    for (int md = 0; md < 4; ++md) { vf[1][md][0] = *(const u32x2*)(vb0 + 16 + md * 32 * VLD); vf[1][md][1] = *(const u32x2*)(vb0 + 16 + md * 32 * VLD + 8); }
                }
                u32x4 pb;
                pb.x = cvt_pk_bf16(sacc[8 * s2 + 0], sacc[8 * s2 + 1]); pb.y = cvt_pk_bf16(sacc[8 * s2 + 2], sacc[8 * s2 + 3]);
                pb.z = cvt_pk_bf16(sacc[8 * s2 + 4], sacc[8 * s2 + 5]); pb.w = cvt_pk_bf16(sacc[8 * s2 + 6], sacc[8 * s2 + 7]);
                const bf16x8 bfrag = __builtin_bit_cast(bf16x8, pb);
                __builtin_amdgcn_sched_barrier(0);
#pragma unroll
                for (int md = 0; md < 4; ++md) {
                    u32x4 av; av.x = vf[s2][md][0].x; av.y = vf[s2][md][0].y; av.z = vf[s2][md][1].x; av.w = vf[s2][md][1].y;
                    O[md] = __builtin_amdgcn_mfma_f32_32x32x16_bf16(__builtin_bit_cast(bf16x8, av), bfrag, O[md], 0, 0, 0);
                }
                __builtin_amdgcn_sched_barrier(0);
            }
        }
        if (j < j_hi) A_LSTORE(A, buf ^ 1);
        __syncthreads();
    }
#undef A_GLOAD
#undef A_LSTORE
    __builtin_amdgcn_s_setprio(0);
    unsigned nxt_item = 0; if (tid_ == 0) nxt_item = atomicAdd(next_ctr, 1u);
    l_run += __shfl_xor(l_run, 32);
    float* mrg = (float*)lds;
    {
        float* mp = mrg + (size_t)((qg * 2 + kh) * 34) * 64 + lane;
        if (kh == 0) {
#pragma unroll
            for (int t2 = 0; t2 < 2; ++t2)
#pragma unroll
                for (int i = 0; i < 16; ++i) mp[(t2 * 16 + i) * 64] = O[2 + t2][i];
        } else {
#pragma unroll
            for (int t2 = 0; t2 < 2; ++t2)
#pragma unroll
                for (int i = 0; i < 16; ++i) mp[(t2 * 16 + i) * 64] = O[t2][i];
        }
        mp[32 * 64] = m_run; mp[33 * 64] = l_run;
    }
    __syncthreads();
    {
        const float* mp = mrg + (size_t)((qg * 2 + (kh ^ 1)) * 34) * 64 + lane;
        const float m1 = mp[32 * 64], l1 = mp[33 * 64];
        const float mt = fmaxf(m_run, m1);
        const float a0 = fast_exp2(m_run - mt), a1 = fast_exp2(m1 - mt);
        const float inv = 1.0f / (l_run * a0 + l1 * a1);
        bf16_t* orow = Op + (size_t)qpos * D;
#define A_MERGE(MD0) do { _Pragma("unroll") for (int t2 = 0; t2 < 2; ++t2) _Pragma("unroll") for (int g4 = 0; g4 < 4; ++g4) { float v[4]; \
            _Pragma("unroll") for (int j = 0; j < 4; ++j) v[j] = (O[(MD0) + t2][g4 * 4 + j] * a0 + mp[(t2 * 16 + g4 * 4 + j) * 64] * a1) * inv; \
            u32x2 w; w.x = cvt_pk_bf16(v[0], v[1]); w.y = cvt_pk_bf16(v[2], v[3]); \
            *(u32x2*)(orow + 32 * ((MD0) + t2) + 8 * g4 + 4 * hh) = w; } } while (0)
        if (kh == 0) A_MERGE(0); else A_MERGE(2);
#undef A_MERGE
    }
    if (tid_ == 0) *slot = nxt_item;
    __syncthreads();
}

__device__ __forceinline__ void attn_phase(PP p, int layer, char* lds, const int tid_) {
    unsigned* cnt = (unsigned*)(p->ws + OFF_CNT) + layer * 8;
    volatile XLAS unsigned* s_item_p = (volatile XLAS unsigned*)&ctl_words + 2;
    const int x0 = (int)(xb_xcc_id() & 7u);
    int k = 0;
    bool have = false;
    for (;;) {
        const int x = (x0 + k) & 7;
        if (!have) {
            if (tid_ == 0) *s_item_p = atomicAdd(cnt + x, 1u);
            __syncthreads();
        }
        const int idx = (int)*s_item_p;
        __syncthreads();
        if (idx >= 128) { have = false; if (++k == 8) break; continue; }
        int tid_i = tid_; asm volatile("" : "+v"(tid_i));
        if (idx < 64) {
            const int qt = 31 - (idx >> 1);
            if ((idx & 1) == 0) attn_item<192, 0>(p, layer, x >> 2, x & 3, qt, lds, tid_i, cnt + x, s_item_p);
            else attn_item<128, 1>(p, layer, x >> 2, x & 3, qt, lds, tid_i, cnt + x, s_item_p);
        } else {
            const int j = idx - 64, qt = 31 - (j >> 1), hs = 2 * x + (j & 1);
            attn_item<128, 2>(p, layer, hs >> 3, hs & 7, qt, lds, tid_i, cnt + x, s_item_p);
        }
        have = true;
    }
}

__device__ __forceinline__ void final_phase(PP p, const int tid_) {
    const float* x = (const float*)(p->ws + OFF_XRES); const float* ss = (const float*)(p->ws + OFF_SS) + 6 * T;
    const int wid = tid_ >> 6, lane = tid_ & 63;
    for (int row = blockIdx.x * 8 + wid; row < T; row += gridDim.x * 8) {
        const float r = rsqrtf(ss[row] * (1.0f / D) + EPS);
#pragma unroll
        for (int i = 0; i < 8; ++i) {
            const int cidx = i * 256 + lane * 4;
            const f32x4 v = *(const f32x4*)(x + (size_t)row * D + cidx), g = *(const f32x4*)(p->final_norm + cidx);
            *(f32x4*)(p->out + (size_t)row * D + cidx) = v * r * g;
        }
    }
}

extern __shared__ __attribute__((aligned(16))) char dyn_lds[];

__global__ void __launch_bounds__(NTHREADS) mega(Params p_arg) {
    cg::grid_group grid = cg::this_grid();
    if (threadIdx.x == 0) ctl_words = make_uint4(0u, 0u, 0u, 0u);
    __syncthreads();
    XcdBarrier xbar = xcd_barrier_post((unsigned*)(p_arg.ws + OFF_BAR), (volatile XLAS unsigned*)&ctl_words);
    if (p_arg.out == nullptr) grid.sync();
#pragma unroll 1
    for (int ph = ((DUP_MASK & 1) ? -1 : 0); ph < 18; ++ph) {
        PP p = (PP)__builtin_amdgcn_kernarg_segment_ptr();
        asm volatile("" : "+s"(p));
        int tid_ = threadIdx.x;
        asm volatile("" : "+v"(tid_));
        const int l = ph <= 0 ? 0 : (ph - 1) / 8, s = ph <= 0 ? -1 : (ph == 17 ? -2 : (ph - 1) % 8);
        const int ncv0 = (int)gridDim.x - NCONV;
        int cv_lo = 0, cv_hi = 0;
        if (s == -1) { cv_lo = 0; cv_hi = CV_P0; }
        else if (s == 0) { cv_lo = l == 0 ? CV_P0 : CV_E7; cv_hi = l == 0 ? CV_E1 : CV_E9; }
        else if (s == 4) { cv_lo = l == 0 ? CV_E1 : CV_E9; cv_hi = l == 0 ? CV_E5 : CV_E13; }
        else if (s == 6) { cv_lo = l == 0 ? CV_E5 : CV_E13; cv_hi = l == 0 ? CV_E7 : CV_E15; }
        const bool has_cv = (s == -1 || s == 0 || s == 4 || s == 6);
        const bool conv = (s == -1) || ((s == 0 || s == 4 || s == 6) && (int)blockIdx.x >= ncv0);
#pragma unroll 1
        for (int pass = 0; pass < 2; ++pass) {
        int tid_p = tid_; asm volatile("" : "+v"(tid_p));
        if (has_cv && ((pass == 0) == conv)) cvt_dyn(p, (float*)dyn_lds, tid_p, cv_lo, cv_hi, (unsigned*)(p->ws + OFF_CNT) + 33 + ph);
        if (pass == 1) break;
        if (ph <= 0) {
#ifndef NO_PREP
            prep_phase(p, (float*)dyn_lds, tid_);
#endif
        } else if (ph == 17) {
            final_phase(p, tid_);
        } else if (!conv) {
            if (s == 4) {
#ifndef NO_ATTN
                attn_phase(p, l, dyn_lds, tid_);
#endif
            } else {
                float* ss = (float*)(p->ws + OFF_SS);
                float* xres = (float*)(p->ws + OFF_XRES);
                bf16_t* xb = (bf16_t*)(p->ws + OFF_XB);
                bf16_t* act = (bf16_t*)(p->ws + OFF_U);
                const char* lw = p->ws + (size_t)l * LW_SIZE;
                GemmDesc d0{}, d1{};
                int n0 = 0, n1 = 0;
                if (s == 0 || s == 6) {
                    d0.A = xb; d0.Bt = (const bf16_t*)(lw + (s == 0 ? LW_GU1 : LW_GU2)); d0.nN = NGU / BM; d0.K = D; d0.epi = 0;
                    d0.ssin = ss + (3 * l + (s == 0 ? 0 : 2)) * T; d0.outb = act; n0 = 32 * (NGU / BM);
                } else if (s == 1 || s == 7) {
                    d0.A = act; d0.Bt = (const bf16_t*)(lw + (s == 1 ? LW_D1 : LW_D2)); d0.nN = D / BM; d0.K = DFF; d0.epi = 1;
                    d0.xin = (l == 0 && s == 1) ? p->x : xres; d0.outf = xres; d0.outb = xb; d0.ssout = ss + (3 * l + (s == 1 ? 1 : 3)) * T; d0.scale = 0.5f;
                    n0 = 32 * (D / BM);
                } else if (s == 2) {
                    d0.A = xb; d0.Bt = (const bf16_t*)(lw + LW_IN); d0.nN = NIN / BM; d0.K = D; d0.epi = 2;
                    d0.ssin = ss + (3 * l + 1) * T; d0.ws = p->ws; d0.layer = l; n0 = 32 * (NIN / BM);
                } else if (s == 3) {
                    d0.A = (const bf16_t*)(p->ws + OFF_CQN); d0.Bt = (const bf16_t*)(lw + LW_UQ); d0.nN = 3; d0.K = 512; d0.epi = 3;
                    d0.outb = (bf16_t*)(p->ws + OFF_QB); d0.ld = 768; d0.ssin = ss + (7 + 2 * l) * T; d0.scale = 1.0f / 512.0f; n0 = 96;
                    d1.A = (const bf16_t*)(p->ws + OFF_CKVN); d1.Bt = (const bf16_t*)(lw + LW_UKV); d1.nN = 4; d1.K = 256; d1.epi = 3;
                    d1.outb = (bf16_t*)(p->ws + OFF_KVB); d1.ld = 1024; d1.ssin = ss + (8 + 2 * l) * T; d1.scale = 1.0f / 256.0f; n1 = 128;
                } else {
                    d0.A = (const bf16_t*)(p->ws + OFF_OB); d0.Bt = (const bf16_t*)(lw + LW_WO); d0.nN = D / BM; d0.K = D; d0.epi = 1;
                    d0.xin = xres; d0.outf = xres; d0.outb = xb; d0.ssout = ss + (3 * l + 2) * T; d0.scale = 1.0f; n0 = 32 * (D / BM);
                }
#ifndef NO_GEMM
                const bool dup_ = (DUP_MASK & 2) && d0.epi == 0;
#pragma unroll 1
                for (int gi = 0; gi < ((n1 || dup_) ? 2 : 1); ++gi) {
                    const GemmDesc& d = (gi && !dup_) ? d1 : d0;
                    int tid_g = tid_; asm volatile("" : "+v"(tid_g));
                    const int Gg = d.epi == 0 ? ncv0 : (int)gridDim.x;
                    gemm_run((LAS unsigned char*)dyn_lds, d.A, d.Bt, 32, d.nN, d.K, Gg, (int)blockIdx.x - ((gi && !dup_) ? n0 : 0), EpiRt{d}, tid_);
                }
#endif
            }
        }
        }
        if (ph < 17) xcd_barrier(xbar);
        if ((DUP_MASK >> 9) & 1) xcd_barrier(xbar);
    }
}

extern "C" void kernel_launch(void* const* d_in, const int* in_sizes, int n_in, void* d_out, int out_size, void* d_ws, size_t ws_size,
                              hipStream_t stream) {
    constexpr size_t kDynLds = GEMM_LDS;
    static int grid_blocks = 0;
    if (!grid_blocks) {
        int dev = 0, cus = 0, per_cu = 0;
        (void)hipGetDevice(&dev);
        (void)hipDeviceGetAttribute(&cus, hipDeviceAttributeMultiprocessorCount, dev);
        (void)hipFuncSetAttribute((const void*)mega, hipFuncAttributeMaxDynamicSharedMemorySize, (int)kDynLds);
        (void)hipOccupancyMaxActiveBlocksPerMultiprocessor(&per_cu, mega, NTHREADS, kDynLds);
        if (per_cu < 1) per_cu = 1;
        grid_blocks = cus;
        if (ws_size < WS_NEED) fprintf(stderr, "workspace too small: %zu < %zu\n", ws_size, (size_t)WS_NEED);
    }
    Params p{};
    p.x = (const float*)d_in[0];
    p.ffn1_norm = (const float*)d_in[1]; p.ffn1_wg = (const float*)d_in[2]; p.ffn1_wu = (const float*)d_in[3]; p.ffn1_wd = (const float*)d_in[4];
    p.attn_norm = (const float*)d_in[5]; p.w_in = (const float*)d_in[6]; p.q_norm = (const float*)d_in[7]; p.w_uq = (const float*)d_in[8];
    p.kv_norm = (const float*)d_in[9]; p.w_ukv = (const float*)d_in[10]; p.sinks = (const float*)d_in[11]; p.w_out = (const float*)d_in[12];
    p.ffn2_norm = (const float*)d_in[13]; p.ffn2_wg = (const float*)d_in[14]; p.ffn2_wu = (const float*)d_in[15]; p.ffn2_wd = (const float*)d_in[16];
    p.final_norm = (const float*)d_in[17];
    p.out = (float*)d_out; p.ws = (char*)d_ws;
    (void)hipMemsetAsync((char*)d_ws + OFF_CNT, 0, CTL_BYTES, stream);
    void* args[] = {&p};
    hipError_t e = hipLaunchCooperativeKernel((const void*)mega, dim3(grid_blocks), dim3(NTHREADS), args, kDynLds, stream);
    if (e != hipSuccess) fprintf(stderr, "cooperative launch failed: %s (grid %d)\n", hipGetErrorString(e), grid_blocks);
}
```

```cpp
#include <hip/hip_runtime.h>
#include <hip/hip_cooperative_groups.h>
#include <cstdio>
#include <cstdint>
namespace cg = cooperative_groups;
#ifndef DUP_MASK
#define DUP_MASK 0
#endif

typedef unsigned short bf16_t;
typedef short bf16x8 __attribute__((ext_vector_type(8)));
typedef float f32x4 __attribute__((ext_vector_type(4)));
typedef float f32x16 __attribute__((ext_vector_type(16)));
typedef unsigned u32x4 __attribute__((ext_vector_type(4)));
typedef unsigned u32x2 __attribute__((ext_vector_type(2)));

constexpr int T = 8192, SEQ = 4096, D = 2048, DFF = 5632, NGU = 2 * DFF, NIN = 4096  , ZW = 3904;
constexpr int NTHREADS = 512;
constexpr float EPS = 1e-6f;
constexpr float LOG2E = 1.4426950408889634f;

constexpr size_t SZ_GU = (size_t)NGU * D * 2, SZ_DN = (size_t)D * DFF * 2, SZ_IN = (size_t)NIN * D * 2, SZ_UQ = 768 * 512 * 2,
                 SZ_UKV = 1024 * 256 * 2, SZ_WO = (size_t)D * D * 2;
constexpr size_t LW_GU1 = 0, LW_D1 = LW_GU1 + SZ_GU, LW_IN = LW_D1 + SZ_DN, LW_UQ = LW_IN + SZ_IN, LW_UKV = LW_UQ + SZ_UQ,
                 LW_WO = LW_UKV + SZ_UKV, LW_GU2 = LW_WO + SZ_WO, LW_D2 = LW_GU2 + SZ_GU, LW_SIZE = LW_D2 + SZ_DN;
constexpr size_t OFF_XRES = 2 * LW_SIZE;
constexpr size_t OFF_XB = OFF_XRES + (size_t)T * D * 4;
constexpr size_t OFF_U = OFF_XB + (size_t)T * D * 2;
constexpr size_t OFF_CQN = OFF_U + (size_t)T * NIN * 4;
constexpr size_t OFF_CKVN = OFF_CQN + (size_t)T * 512 * 2;
constexpr size_t OFF_KPE = OFF_CKVN + (size_t)T * 256 * 2;
constexpr size_t OFF_MQ = OFF_KPE + (size_t)T * 64 * 2;
constexpr size_t OFF_MK = OFF_MQ + (size_t)T * 512 * 2;
constexpr size_t OFF_MV = OFF_MK + (size_t)T * 512 * 2;
constexpr size_t OFF_SQ = OFF_MV + (size_t)T * 512 * 2;
constexpr size_t OFF_SK = OFF_SQ + (size_t)T * 1024 * 2;
constexpr size_t OFF_SV = OFF_SK + (size_t)T * 256 * 2;
constexpr size_t OFF_KBAR = OFF_SV + (size_t)T * 256 * 2;
constexpr size_t OFF_QB = OFF_KBAR + 2 * 4 * 16 * 128 * 2;
constexpr size_t OFF_KVB = OFF_QB + (size_t)T * 768 * 2;
constexpr size_t OFF_OB = OFF_KVB + (size_t)T * 1024 * 2;
constexpr size_t OFF_SS = OFF_OB + (size_t)T * D * 2;
constexpr size_t OFF_R128 = OFF_SS + 11 * (size_t)T * 4;
constexpr size_t OFF_R64 = OFF_R128 + (size_t)SEQ * 64 * 2 * 4;
constexpr size_t OFF_CNT = OFF_R64 + (size_t)SEQ * 32 * 2 * 4;
constexpr size_t OFF_BAR = OFF_CNT + 256;
constexpr size_t OFF_KBARF = OFF_BAR + 3456 * 4;
constexpr size_t CTL_BYTES = 256 + 3456 * 4 + 2 * 16384 * 4;
constexpr size_t WS_NEED = OFF_CNT + CTL_BYTES;

struct Params {
    const float* x;
    const float* ffn1_norm; const float* ffn1_wg; const float* ffn1_wu; const float* ffn1_wd;
    const float* attn_norm; const float* w_in; const float* q_norm; const float* w_uq; const float* kv_norm; const float* w_ukv;
    const float* sinks; const float* w_out;
    const float* ffn2_norm; const float* ffn2_wg; const float* ffn2_wu; const float* ffn2_wd;
    const float* final_norm;
    float* out; char* ws;
};
typedef const __attribute__((address_space(4))) Params* PP;

__device__ __forceinline__ unsigned cvt_pk_bf16(float lo, float hi) { unsigned r; asm volatile("v_cvt_pk_bf16_f32 %0, %1, %2" : "=v"(r) : "v"(lo), "v"(hi)); return r; }
__device__ __forceinline__ bf16_t cvt_bf16(float v) { return (bf16_t)(cvt_pk_bf16(v, 0.f) & 0xffffu); }
__device__ __forceinline__ float bf16_lo(unsigned w) { return __uint_as_float(w << 16); }
__device__ __forceinline__ float bf16_hi(unsigned w) { return __uint_as_float(w & 0xffff0000u); }
__device__ __forceinline__ float fast_exp2(float x) { return __builtin_amdgcn_exp2f(x); }
__device__ __forceinline__ void sincos_rr(float ang, float& cs, float& sn) {
    const double rev = (double)ang * 0.15915494309189533577;
    const float fr = (float)(rev - floor(rev));
    sn = __builtin_amdgcn_sinf(fr); cs = __builtin_amdgcn_cosf(fr);
}


#define XB_TMO      128
#define XB_XCNT(j)  (256  + 64 * (j))
#define XB_XSUB(j)  (1280 + 64 * (j))
#define XB_XGEN(j)  (2304 + 64 * (j))
#define XB_TOP      3328
#define XB_TOPGEN   3392
#define XCD_BAR_WORDS 3456
#define XB_SPIN_CAP (1u << 18)
#define XLAS __attribute__((address_space(3)))
__device__ __forceinline__ unsigned xb_ld(unsigned* p)              { return __hip_atomic_load(p, __ATOMIC_RELAXED, __HIP_MEMORY_SCOPE_AGENT); }
__device__ __forceinline__ unsigned xb_add(unsigned* p, unsigned v) { return __hip_atomic_fetch_add(p, v, __ATOMIC_RELAXED, __HIP_MEMORY_SCOPE_AGENT); }
__device__ __forceinline__ unsigned xb_xcc_id() { return (unsigned)__builtin_amdgcn_s_getreg((3 << 11) | 20) & 0xFu; }
#define XB_SPIN(cond, bar) do { unsigned _sp = 0; while (cond) { __builtin_amdgcn_s_sleep(1); \
    if ((++_sp & 255u) == 0u) { if (xb_ld(&(bar)[XB_TMO])) break; if (_sp > XB_SPIN_CAP) { atomicAdd(&(bar)[XB_TMO], 1u); break; } } } } while (0)
struct XcdBarrier { unsigned* bar; unsigned x; volatile XLAS unsigned* st; };
__device__ __forceinline__ XcdBarrier xcd_barrier_post(unsigned* bar, volatile XLAS unsigned* st) {
    XcdBarrier b; b.bar = bar; b.x = xb_xcc_id(); b.st = st;
    if (threadIdx.x == 0) (void)xb_add(&bar[XB_XCNT(b.x)], 1u);
    return b;
}
__device__ __forceinline__ void xcd_barrier_complete(unsigned* bar, unsigned x, unsigned& nloc, unsigned& nx) {
    const unsigned G = gridDim.x * gridDim.y * gridDim.z;
    unsigned sum, cnt, mine, sp = 0u;
    for (;;) {
        sum = 0u; cnt = 0u; mine = 0u;
#pragma unroll
        for (unsigned j = 0; j < 16; ++j) { const unsigned c = xb_ld(&bar[XB_XCNT(j)]); sum += c; cnt += (c > 0u) ? 1u : 0u; mine = (j == x) ? c : mine; }
        if (sum == G) break;
        __builtin_amdgcn_s_sleep(1);
        if ((++sp & 255u) == 0u) { if (xb_ld(&bar[XB_TMO])) break; if (sp > XB_SPIN_CAP) { atomicAdd(&bar[XB_TMO], 1u); break; } }
    }
    nloc = mine > 0u ? mine : 1u; nx = cnt > 0u ? cnt : 1u;
}
__device__ __forceinline__ void xcd_barrier(const XcdBarrier& b) {
    asm volatile("s_waitcnt vmcnt(0)" ::: "memory");
    __syncthreads();
    if (threadIdx.x == 0) {
        unsigned* bar = b.bar;
        __builtin_amdgcn_s_waitcnt(0);
        unsigned nloc = b.st[0], nx = b.st[1];
        if (nloc == 0u) { xcd_barrier_complete(bar, b.x, nloc, nx); b.st[0] = nloc; b.st[1] = nx; }
        const unsigned old = xb_add(&bar[XB_XSUB(b.x)], 1u);
        const unsigned gen = old / nloc;
        if (old + 1u == (gen + 1u) * nloc) {
            __builtin_amdgcn_fence(__ATOMIC_RELEASE, "agent");
            asm volatile("s_waitcnt vmcnt(0)" ::: "memory");
            const unsigned og = xb_add(&bar[XB_TOP], 1u);
            const unsigned tg = og / nx;
            if (og + 1u == (tg + 1u) * nx) xb_add(&bar[XB_TOPGEN], 1u);
            else XB_SPIN(xb_ld(&bar[XB_TOPGEN]) == tg, bar);
            __builtin_amdgcn_fence(__ATOMIC_ACQUIRE, "agent");
            xb_add(&bar[XB_XGEN(b.x)], 1u);
            asm volatile("s_waitcnt vmcnt(0)" ::: "memory");
        } else {
            XB_SPIN(xb_ld(&bar[XB_XGEN(b.x)]) == gen, bar);
            __builtin_amdgcn_fence(__ATOMIC_ACQUIRE, "agent");
            asm volatile("s_waitcnt vmcnt(0)" ::: "memory");
        }
    }
    __syncthreads();
}

constexpr int BM = 256, BK = 64, HALF = 128, NXCD = 8, WGM = 4, HT = HALF * BK;
constexpr int GEMM_LDS = 8 * HT * 2;

__device__ __forceinline__ int lds_byte(int r, int c) {
    int st = (r >> 4) * 2 + (c >> 5), rr = r & 15, cc = c & 31, ob = rr * 64 + cc * 2;
    return st * 1024 + (ob ^ (((ob >> 9) & 1) << 5));
}
__device__ __forceinline__ void stage_rc(int b, int& R, int& C) {
    int st = b / 1024, sb = b % 1024, swz = sb ^ (((sb >> 9) & 1) << 5);
    R = (st >> 1) * 16 + swz / 64; C = (st & 1) * 32 + (swz % 64) / 2;
}

#define LAS __attribute__((address_space(3)))
struct Unit { int pm, pn; };
__device__ __forceinline__ void tile_order(int L, int nM, int nN, int& pm, int& pn) {
    const int nwg = nM * nN; int wgid = L;
    { const int q = nwg / NXCD, r = nwg % NXCD, xcd = wgid % NXCD, off = wgid / NXCD; wgid = (xcd < r ? xcd * (q + 1) : r * (q + 1) + (xcd - r) * q) + off; }
    const int nig = WGM * nN, gid = wgid / nig, fm = gid * WGM, gsz = (nM - fm) < WGM ? (nM - fm) : WGM;
    pm = fm + ((wgid % nig) % gsz); pn = (wgid % nig) / gsz;
}
__device__ __forceinline__ bool unit_next(int i, int G, int c, int nM, int nN, Unit& u) {
    const long L = (long)i * G + c; if (c < 0 || L >= (long)nM * nN) return false;
    tile_order((int)L, nM, nN, u.pm, u.pn); return true;
}

constexpr int HTB = HALF * BK * 2;
template <class Epi>
__device__ __forceinline__ void gemm_run(LAS unsigned char* lds, const bf16_t* gA, const bf16_t* gBt, const int nM, const int nN, const int K, const int G, const int c, const Epi& E, const int tid_) {
    const int tid = tid_, wid = __builtin_amdgcn_readfirstlane(tid >> 6), lane = tid & 63, wr = wid >> 2, wc = wid & 3, fr = lane & 15, fq = lane >> 4;
    const int nt = K / BK;
    unsigned voffA[2];
#pragma unroll
    for (int i = 0; i < 2; ++i) { int R, C; stage_rc(tid * 16 + i * 8192, R, C); voffA[i] = (unsigned)(R * K + C) * 2u; }
    const size_t kstep = (size_t)(BK * 2);
    const size_t hstep = (size_t)HALF * K * 2;
    const size_t tstep = 2 * hstep;
    const unsigned ldsw = (unsigned)wid * 1024u;
    const int aoff = lds_byte(wr * 64 + fr, fq * 8), boff = lds_byte(wc * 32 + fr, fq * 8);
#define PG8_SA(b, h) (((b) * 2 + (h)) * HTB)
#define PG8_SB(b, h) ((4 + (b) * 2 + (h)) * HTB)
#define PG8_STAGE(bufoff, gbase) do { _Pragma("unroll") for (int _i = 0; _i < 2; ++_i) \
        __builtin_amdgcn_global_load_lds((const unsigned*)((const char*)(gbase) + voffA[_i]), (LAS unsigned*)(lds + (bufoff) + ldsw + _i * 8192), 16, 0, 0); } while (0)
#define PG8_LDA(dst, b, h) do { _Pragma("unroll") for (int m = 0; m < 4; ++m) _Pragma("unroll") for (int k = 0; k < 2; ++k) dst[m][k] = *(const LAS bf16x8*)(lds + PG8_SA(b, h) + aoff + m * 2048 + k * 1024); } while (0)
#define PG8_LDB(dst, b, h) do { _Pragma("unroll") for (int n = 0; n < 2; ++n) _Pragma("unroll") for (int k = 0; k < 2; ++k) dst[n][k] = *(const LAS bf16x8*)(lds + PG8_SB(b, h) + boff + n * 2048 + k * 1024); } while (0)
#define PG8_MMA(ai, bj, At, Bt) do { __builtin_amdgcn_s_setprio(1); _Pragma("unroll") for (int m = 0; m < 4; ++m) _Pragma("unroll") for (int n = 0; n < 2; ++n) _Pragma("unroll") for (int k = 0; k < 2; ++k) \
        acc[ai][bj][m][n] = __builtin_amdgcn_mfma_f32_16x16x32_bf16(Bt[n][k], At[m][k], acc[ai][bj][m][n], 0, 0, 0); __builtin_amdgcn_s_setprio(0); } while (0)
#define PG8_WAIT_V(n) asm volatile("s_waitcnt vmcnt(" #n ")" ::: "memory")
#define PG8_WAIT_L(n) asm volatile("s_waitcnt lgkmcnt(" #n ")" ::: "memory")
#define PG8_BAR __builtin_amdgcn_s_barrier()
#define PG8_SCHED __builtin_amdgcn_sched_barrier(0)
    Unit cur, nxt; int ui = 0;
    if (!unit_next(0, G, c, nM, nN, cur)) return;
    f32x4 acc[2][2][4][2];
#pragma unroll
    for (int a = 0; a < 2; ++a)
#pragma unroll
        for (int b = 0; b < 2; ++b)
#pragma unroll
            for (int m = 0; m < 4; ++m)
#pragma unroll
                for (int n = 0; n < 2; ++n) acc[a][b][m][n] = (f32x4){0.f, 0.f, 0.f, 0.f};
    bf16x8 At[4][2], B0[2][2], B1[2][2];
    const char* cA = (const char*)gA + (size_t)cur.pm * tstep; const char* cB = (const char*)gBt + (size_t)cur.pn * tstep;
    PG8_STAGE(PG8_SB(0, 0), cB); PG8_STAGE(PG8_SB(0, 1), cB + hstep); PG8_STAGE(PG8_SA(0, 0), cA); PG8_STAGE(PG8_SA(0, 1), cA + hstep);
    if (wr == 1) PG8_BAR;
    PG8_WAIT_V(2); PG8_BAR;
    PG8_STAGE(PG8_SB(1, 0), cB + kstep); PG8_STAGE(PG8_SA(1, 0), cA + kstep); PG8_STAGE(PG8_SB(1, 1), cB + hstep + kstep);
    PG8_WAIT_V(6); PG8_BAR;
    for (;;) {
        const bool has_next = unit_next(ui + 1, G, c, nM, nN, nxt);
        const char* nA = has_next ? (const char*)gA + (size_t)nxt.pm * tstep : cA; const char* nB = has_next ? (const char*)gBt + (size_t)nxt.pn * tstep : cB;
#pragma unroll 1
        for (int t = 0; t < nt; t += 2) {
            const bool last = (t == nt - 2);
            const char* a1 = cA + (size_t)(t + 1) * kstep;
            const char* a2 = last ? nA : cA + (size_t)(t + 2) * kstep; const char* b2 = last ? nB : cB + (size_t)(t + 2) * kstep;
            const char* a3 = a2 + kstep; const char* b3 = b2 + kstep;
            PG8_LDB(B0, 0, 0); PG8_LDB(B1, 0, 1); PG8_SCHED; PG8_LDA(At, 0, 0); PG8_STAGE(PG8_SA(1, 1), a1 + hstep);
            PG8_WAIT_V(8); PG8_WAIT_L(0); PG8_BAR; PG8_MMA(0, 0, At, B0); PG8_MMA(0, 1, At, B1); PG8_BAR; PG8_SCHED;
            PG8_LDA(At, 0, 1); PG8_STAGE(PG8_SB(0, 0), b2); PG8_STAGE(PG8_SB(0, 1), b2 + hstep); PG8_STAGE(PG8_SA(0, 0), a2);
            PG8_WAIT_V(8); PG8_WAIT_L(0); PG8_BAR; PG8_MMA(1, 0, At, B0); PG8_MMA(1, 1, At, B1); PG8_BAR; PG8_SCHED;
            PG8_LDB(B0, 1, 0); PG8_LDB(B1, 1, 1); PG8_SCHED; PG8_LDA(At, 1, 0); PG8_STAGE(PG8_SA(0, 1), a2 + hstep);
            PG8_WAIT_V(8); PG8_WAIT_L(0); PG8_BAR; PG8_MMA(0, 0, At, B0); PG8_MMA(0, 1, At, B1); PG8_BAR; PG8_SCHED;
            PG8_LDA(At, 1, 1); PG8_STAGE(PG8_SB(1, 0), b3); PG8_STAGE(PG8_SB(1, 1), b3 + hstep); PG8_STAGE(PG8_SA(1, 0), a3);
            PG8_WAIT_V(8); PG8_WAIT_L(0); PG8_BAR; PG8_MMA(1, 0, At, B0); PG8_MMA(1, 1, At, B1); PG8_BAR; PG8_SCHED;
        }
        if (wr == 0) PG8_BAR;
        E(acc, cur.pm * BM, cur.pn * BM, wr, wc, fr, fq);
        if (!has_next) break;
#pragma unroll
        for (int a = 0; a < 2; ++a)
#pragma unroll
            for (int b = 0; b < 2; ++b)
#pragma unroll
                for (int m = 0; m < 4; ++m)
#pragma unroll
                    for (int n = 0; n < 2; ++n) acc[a][b][m][n] = (f32x4){0.f, 0.f, 0.f, 0.f};
        cur = nxt; cA = nA; cB = nB; ++ui;
        if (wr == 1) PG8_BAR;
    }
    PG8_WAIT_V(0);
    PG8_BAR;
#undef PG8_SA
#undef PG8_SB
#undef PG8_STAGE
#undef PG8_LDA
#undef PG8_LDB
#undef PG8_MMA
}

struct GemmDesc {
    const bf16_t* A; const bf16_t* Bt; int nN; int K; int epi;
    const float* ssin; const float* xin; float* outf; bf16_t* outb; float* ssout; float scale; int ld; char* ws; int layer;
};
template <bool KB>
__device__ __forceinline__ void epi_rope128(const f32x4 (&acc)[2][2][4][2], const float* ssin, char* ws, bf16_t* dst, int ld, int dcol, int layer, int pn,
                                            int brow, int wr, int wc, int fr, int fq) {
                const float* r128 = (const float*)(ws + OFF_R128);
                const int hsel = wc >> 1, fb = (wc & 1) * 32 + fq * 4;
                f32x4 ks1[2], ks2[2];
#pragma unroll
                for (int n = 0; n < 2; ++n) { ks1[n] = (f32x4){0.f, 0.f, 0.f, 0.f}; ks2[n] = (f32x4){0.f, 0.f, 0.f, 0.f}; }
                float rs[8];
#pragma unroll
                for (int i8 = 0; i8 < 8; ++i8) rs[i8] = ssin[brow + (i8 >> 2) * HALF + wr * 64 + (i8 & 3) * 16 + fr];
                f32x4 tb[2][2][2];
                {
                    const int pos0 = (brow + wr * 64 + fr) & (SEQ - 1);
#pragma unroll
                    for (int n = 0; n < 2; ++n) { const float* tp = r128 + ((size_t)pos0 * 64 + fb + n * 16) * 2; tb[0][n][0] = *(const f32x4*)tp; tb[0][n][1] = *(const f32x4*)(tp + 4); }
                }
#pragma unroll
                for (int ai = 0; ai < 2; ++ai)
#pragma unroll
                    for (int m = 0; m < 4; ++m) {
                        const int it8 = ai * 4 + m, cur = it8 & 1;
                        const int row = brow + ai * HALF + wr * 64 + m * 16 + fr;
                        if (it8 < 7) {
                            const int nrow = brow + ((it8 + 1) >> 2) * HALF + wr * 64 + ((it8 + 1) & 3) * 16 + fr, npos = nrow & (SEQ - 1);
#pragma unroll
                            for (int n = 0; n < 2; ++n) { const float* tp = r128 + ((size_t)npos * 64 + fb + n * 16) * 2; tb[cur ^ 1][n][0] = *(const f32x4*)tp; tb[cur ^ 1][n][1] = *(const f32x4*)(tp + 4); }
                        }
                        const float r = rsqrtf(rs[it8] * (1.0f / D) + EPS);
#pragma unroll
                        for (int n = 0; n < 2; ++n) {
                            const int f0 = fb + n * 16;
                            const f32x4 ca = tb[cur][n][0], cb = tb[cur][n][1];
                            const f32x4 x1 = acc[ai][0][m][n] * r, x2 = acc[ai][1][m][n] * r;
                            f32x4 o1, o2;
                            o1[0] = x1[0] * ca[0] - x2[0] * ca[1]; o2[0] = x2[0] * ca[0] + x1[0] * ca[1];
                            o1[1] = x1[1] * ca[2] - x2[1] * ca[3]; o2[1] = x2[1] * ca[2] + x1[1] * ca[3];
                            o1[2] = x1[2] * cb[0] - x2[2] * cb[1]; o2[2] = x2[2] * cb[0] + x1[2] * cb[1];
                            o1[3] = x1[3] * cb[2] - x2[3] * cb[3]; o2[3] = x2[3] * cb[2] + x1[3] * cb[3];
                            u32x2 w1, w2; w1.x = cvt_pk_bf16(o1[0], o1[1]); w1.y = cvt_pk_bf16(o1[2], o1[3]); w2.x = cvt_pk_bf16(o2[0], o2[1]); w2.y = cvt_pk_bf16(o2[2], o2[3]);
                            bf16_t* op = dst + (size_t)row * ld + dcol + hsel * 128 + f0;
                            *(u32x2*)op = w1; *(u32x2*)(op + 64) = w2;
                            if (KB) { ks1[n] += o1; ks2[n] += o2;
                                asm volatile("" : "+v"(ks1[n][0]), "+v"(ks1[n][1]), "+v"(ks1[n][2]), "+v"(ks1[n][3]), "+v"(ks2[n][0]), "+v"(ks2[n][1]), "+v"(ks2[n][2]), "+v"(ks2[n][3])); }
                        }
                        __builtin_amdgcn_sched_barrier(0);
                    }
                if (KB) {
                    float* kb = (float*)(ws + OFF_KBARF) + (size_t)layer * 16384 + ((size_t)((brow >> 12) * 4 + (pn - 5) * 2 + hsel) * 16 + ((brow & (SEQ - 1)) >> 8)) * 128;
#pragma unroll
                    for (int n = 0; n < 2; ++n)
#pragma unroll
                        for (int j = 0; j < 4; ++j) {
                            float a = ks1[n][j], b2 = ks2[n][j];
#pragma unroll
                            for (int o = 1; o < 16; o <<= 1) { a += __shfl_xor(a, o); b2 += __shfl_xor(b2, o); }
                            if (fr == 0) { atomicAdd(kb + fb + n * 16 + j, a); atomicAdd(kb + 64 + fb + n * 16 + j, b2); }
                        }
                }
}

struct EpiRt {
    const GemmDesc& d;
    __device__ __forceinline__ void operator()(const f32x4 (&acc)[2][2][4][2], int brow, int bcol, int wr, int wc, int fr, int fq) const {
        asm volatile("" : "+s"(brow), "+s"(bcol), "+s"(wr), "+s"(wc));
        asm volatile("" : "+v"(fr), "+v"(fq));
        if (d.epi == 0) {
            const int cbase = (bcol >> 1) + wc * 32 + fq * 8;
            float rs[8];
#pragma unroll
            for (int i8 = 0; i8 < 8; ++i8) rs[i8] = d.ssin[brow + (i8 >> 2) * HALF + wr * 64 + (i8 & 3) * 16 + fr];
#pragma unroll
            for (int ai = 0; ai < 2; ++ai)
#pragma unroll
                for (int m = 0; m < 4; ++m) {
                    const int row = brow + ai * HALF + wr * 64 + m * 16 + fr;
                    const float r = rsqrtf(rs[ai * 4 + m] * (1.0f / D) + EPS);
                    u32x4 w;
#pragma unroll
                    for (int bj = 0; bj < 2; ++bj) {
                        const f32x4 g = acc[ai][bj][m][0] * r, u = acc[ai][bj][m][1] * r;
                        float a[4];
#pragma unroll
                        for (int j = 0; j < 4; ++j) a[j] = g[j] * u[j] * __builtin_amdgcn_rcpf(1.0f + fast_exp2(g[j] * -LOG2E));
                        if (bj == 0) { w.x = cvt_pk_bf16(a[0], a[1]); w.y = cvt_pk_bf16(a[2], a[3]); } else { w.z = cvt_pk_bf16(a[0], a[1]); w.w = cvt_pk_bf16(a[2], a[3]); }
                    }
                    *(u32x4*)(d.outb + (size_t)row * DFF + cbase) = w;
                }
        } else if (d.epi == 1) {
#pragma unroll
            for (int ai = 0; ai < 2; ++ai) {
                f32x4 xo[4][2][2];
#pragma unroll
                for (int m = 0; m < 4; ++m) {
                    const int row = brow + ai * HALF + wr * 64 + m * 16 + fr;
#pragma unroll
                    for (int bj = 0; bj < 2; ++bj)
#pragma unroll
                        for (int n = 0; n < 2; ++n)
                            xo[m][bj][n] = *(const f32x4*)(d.xin + (size_t)row * D + bcol + bj * HALF + wc * 32 + n * 16 + fq * 4);
                }
                float sqv[4];
#pragma unroll
                for (int m = 0; m < 4; ++m) {
                    const int row = brow + ai * HALF + wr * 64 + m * 16 + fr;
                    float sq = 0.f;
#pragma unroll
                    for (int bj = 0; bj < 2; ++bj)
#pragma unroll
                        for (int n = 0; n < 2; ++n) {
                            const size_t o = (size_t)row * D + bcol + bj * HALF + wc * 32 + n * 16 + fq * 4;
                            const f32x4 xn = xo[m][bj][n] + acc[ai][bj][m][n] * d.scale;
                            *(f32x4*)(d.outf + o) = xn;
                            u32x2 w; w.x = cvt_pk_bf16(xn[0], xn[1]); w.y = cvt_pk_bf16(xn[2], xn[3]);
                            *(u32x2*)(d.outb + o) = w;
                            sq += xn[0] * xn[0] + xn[1] * xn[1] + xn[2] * xn[2] + xn[3] * xn[3];
                        }
                    sq += __shfl_xor(sq, 16); sq += __shfl_xor(sq, 32);
                    sqv[m] = sq;
                }
                if (fq == 0) {
#pragma unroll
                    for (int m = 0; m < 4; ++m) atomicAdd(d.ssout + brow + ai * HALF + wr * 64 + m * 16 + fr, sqv[m]);
                }
            }
        } else if (d.epi == 2) {
            const int pn = bcol >> 8;
            char* ws = d.ws;
            int kind, dcol = 0, ld = 0; bf16_t* dst; float* ssx = nullptr; bool iskb = false;
            if (pn < 2)        { kind = 0; dst = (bf16_t*)(ws + OFF_CQN);  ld = 512;  dcol = pn * 256; ssx = (float*)(ws + OFF_SS) + (7 + 2 * d.layer) * T; }
            else if (pn == 2)  { kind = 0; dst = (bf16_t*)(ws + OFF_CKVN); ld = 256;  ssx = (float*)(ws + OFF_SS) + (8 + 2 * d.layer) * T; }
            else if (pn < 5)   { kind = 1; dst = (bf16_t*)(ws + OFF_MQ);   ld = 512;  dcol = (pn - 3) * 256; }
            else if (pn < 7)   { kind = 1; dst = (bf16_t*)(ws + OFF_MK);   ld = 512;  dcol = (pn - 5) * 256; iskb = true; }
            else if (pn < 9)   { kind = 2; dst = (bf16_t*)(ws + OFF_MV);   ld = 512;  dcol = (pn - 7) * 256; }
            else if (pn < 13)  { kind = 1; dst = (bf16_t*)(ws + OFF_SQ);   ld = 1024; dcol = (pn - 9) * 256; }
            else if (pn == 13) { kind = 1; dst = (bf16_t*)(ws + OFF_SK);   ld = 256; }
            else if (pn == 14) { kind = 2; dst = (bf16_t*)(ws + OFF_SV);   ld = 256; }
            else               { kind = 3; dst = (bf16_t*)(ws + OFF_KPE);  ld = 64; }
            if (kind == 0 || kind == 2) {
#pragma unroll
                for (int ai = 0; ai < 2; ++ai)
#pragma unroll
                    for (int m = 0; m < 4; ++m) {
                        const int row = brow + ai * HALF + wr * 64 + m * 16 + fr;
                        const float r = rsqrtf(d.ssin[row] * (1.0f / D) + EPS);
                        float sq = 0.f;
#pragma unroll
                        for (int bj = 0; bj < 2; ++bj)
#pragma unroll
                            for (int n = 0; n < 2; ++n) {
                                const f32x4 v = acc[ai][bj][m][n] * r;
                                u32x2 w; w.x = cvt_pk_bf16(v[0], v[1]); w.y = cvt_pk_bf16(v[2], v[3]);
                                *(u32x2*)(dst + (size_t)row * ld + dcol + bj * HALF + wc * 32 + n * 16 + fq * 4) = w;
                                sq += v[0] * v[0] + v[1] * v[1] + v[2] * v[2] + v[3] * v[3];
                            }
                        if (kind == 0) { sq += __shfl_xor(sq, 16); sq += __shfl_xor(sq, 32); if (fq == 0) atomicAdd(ssx + row, sq); }
                    }
            } else if (kind == 1) {
                if (iskb) epi_rope128<true>(acc, d.ssin, ws, dst, ld, dcol, d.layer, pn, brow, wr, wc, fr, fq);
                else epi_rope128<false>(acc, d.ssin, ws, dst, ld, dcol, d.layer, pn, brow, wr, wc, fr, fq);
            } else {
                const float* r64 = (const float*)(ws + OFF_R64);
                if (wc == 0) {
#pragma unroll
                    for (int ai = 0; ai < 2; ++ai)
#pragma unroll
                        for (int m = 0; m < 4; ++m) {
                            const int row = brow + ai * HALF + wr * 64 + m * 16 + fr, pos = row & (SEQ - 1);
                            const float r = rsqrtf(d.ssin[row] * (1.0f / D) + EPS);
#pragma unroll
                            for (int n = 0; n < 2; ++n) {
                                const int f0 = n * 16 + fq * 4;
                                const f32x4 ca = *(const f32x4*)(r64 + ((size_t)pos * 32 + f0) * 2), cb = *(const f32x4*)(r64 + ((size_t)pos * 32 + f0) * 2 + 4);
                                const f32x4 x1 = acc[ai][0][m][n] * r, x2 = acc[ai][1][m][n] * r;
                                f32x4 o1, o2;
                                o1[0] = x1[0] * ca[0] - x2[0] * ca[1]; o2[0] = x2[0] * ca[0] + x1[0] * ca[1];
                                o1[1] = x1[1] * ca[2] - x2[1] * ca[3]; o2[1] = x2[1] * ca[2] + x1[1] * ca[3];
                                o1[2] = x1[2] * cb[0] - x2[2] * cb[1]; o2[2] = x2[2] * cb[0] + x1[2] * cb[1];
                                o1[3] = x1[3] * cb[2] - x2[3] * cb[3]; o2[3] = x2[3] * cb[2] + x1[3] * cb[3];
                                u32x2 w1, w2; w1.x = cvt_pk_bf16(o1[0], o1[1]); w1.y = cvt_pk_bf16(o1[2], o1[3]); w2.x = cvt_pk_bf16(o2[0], o2[1]); w2.y = cvt_pk_bf16(o2[2], o2[3]);
                                bf16_t* op = dst + (size_t)row * 64 + f0;
                                *(u32x2*)op = w1; *(u32x2*)(op + 32) = w2;
                            }
                        }
                }
            }
        } else {
#pragma unroll
            for (int ai = 0; ai < 2; ++ai)
#pragma unroll
                for (int m = 0; m < 4; ++m) {
                    const int row = brow + ai * HALF + wr * 64 + m * 16 + fr;
                    const float r = rsqrtf(d.ssin[row] * d.scale + EPS);
#pragma unroll
                    for (int bj = 0; bj < 2; ++bj)
#pragma unroll
                        for (int n = 0; n < 2; ++n) {
                            const f32x4 v = acc[ai][bj][m][n] * r;
                            u32x2 w; w.x = cvt_pk_bf16(v[0], v[1]); w.y = cvt_pk_bf16(v[2], v[3]);
                            *(u32x2*)(d.outb + (size_t)row * d.ld + bcol + bj * HALF + wc * 32 + n * 16 + fq * 4) = w;
                        }
                }
        }
    }
};

struct ColPlain { const float* W; int ncols; __device__ __forceinline__ const float* operator()(int n) const { return n < ncols ? W + n : nullptr; } };
struct ColGateUp { const float* Wg; const float* Wu;
    __device__ __forceinline__ const float* operator()(int n) const {
        const int pn = n >> 8, p = n & 255, bj = p >> 7, wc = (p >> 5) & 3, nn = (p >> 4) & 1, q4 = p & 15;
        const int col = pn * 128 + wc * 32 + (q4 >> 2) * 8 + bj * 4 + (q4 & 3);
        const uintptr_t a = (uintptr_t)Wg, b = (uintptr_t)Wu;
        return (const float*)(a ^ ((a ^ b) & (uintptr_t)0 - (uintptr_t)nn)) + col;
    } };

__device__ __forceinline__ int win_col(int n) {
    const int tile = n >> 8, p = n & 255, bj = p >> 7, q = p & 127;
    const int rope = (q >> 6) * 128 + (q & 63) + 64 * bj;
    if (tile < 3) return n;
    if (tile < 5) return 832 + (tile - 3) * 256 + rope;
    if (tile < 7) return 1344 + (tile - 5) * 256 + rope;
    if (tile < 9) return 1856 + (tile - 7) * 256 + p;
    if (tile < 13) return 2368 + (tile - 9) * 256 + rope;
    if (tile == 13) return 3392 + rope;
    if (tile == 14) return 3648 + p;
    return q < 32 ? 768 + q + 32 * bj : -1;
}
struct CvtItem { const float* src; const float* gain; bf16_t* dst; int ldw, K, n0, k0; };
__device__ __forceinline__ void cvt_decode(PP p, int it, int n4, CvtItem& c) {
    constexpr int I_GU = (NGU / 64) * (D / 256), I_DN = (D / 64) * (DFF / 256), I_IN = (NIN / 64) * (D / 256), I_UQ = (768 / 64) * (512 / 256),
                  I_UKV = (1024 / 64) * (256 / 256), I_WO = (D / 64) * (D / 256);
    constexpr int C0 = I_GU, C1 = C0 + I_DN, C2 = C1 + I_IN, C3 = C2 + I_UQ, C4 = C3 + I_UKV, C5 = C4 + I_WO, C6 = C5 + I_GU, C7 = C6 + I_DN;
    const int l = it / C7; int r = it - l * C7;
    char* lw = p->ws + (size_t)l * LW_SIZE;
    c.gain = nullptr;
    if (r < C0 || (r >= C5 && r < C6)) {
        const bool second = r >= C5; if (second) r -= C5;
        const int nb = r % (NGU / 64), kb = r / (NGU / 64);
        ColGateUp cm{(second ? p->ffn2_wg : p->ffn1_wg) + (size_t)l * D * DFF, (second ? p->ffn2_wu : p->ffn1_wu) + (size_t)l * D * DFF};
        c.src = cm(nb * 64 + n4); c.ldw = DFF; c.gain = (second ? p->ffn2_norm : p->ffn1_norm) + l * D; c.dst = (bf16_t*)(lw + (second ? LW_GU2 : LW_GU1)); c.K = D; c.n0 = nb * 64; c.k0 = kb * 256;
    } else if (r < C1 || r >= C6) {
        const bool second = r >= C6; r -= second ? C6 : C0;
        const int nb = r % (D / 64), kb = r / (D / 64);
        c.src = (second ? p->ffn2_wd : p->ffn1_wd) + (size_t)l * DFF * D + nb * 64 + n4; c.ldw = D; c.dst = (bf16_t*)(lw + (second ? LW_D2 : LW_D1)); c.K = DFF; c.n0 = nb * 64; c.k0 = kb * 256;
    } else if (r < C2) {
        r -= C1; const int nb = r % (NIN / 64), kb = r / (NIN / 64);
        const int n = nb * 64 + n4;
        const int col = win_col(n);
        c.src = col >= 0 ? p->w_in + (size_t)l * D * ZW + col : nullptr; c.ldw = ZW; c.gain = p->attn_norm + l * D; c.dst = (bf16_t*)(lw + LW_IN); c.K = D; c.n0 = nb * 64; c.k0 = kb * 256;
    } else if (r < C3) {
        r -= C2; const int nb = r % (768 / 64), kb = r / (768 / 64);
        c.src = p->w_uq + (size_t)l * 512 * 768 + nb * 64 + n4; c.ldw = 768; c.gain = p->q_norm + l * 512; c.dst = (bf16_t*)(lw + LW_UQ); c.K = 512; c.n0 = nb * 64; c.k0 = kb * 256;
    } else if (r < C4) {
        r -= C3; const int nb = r % (1024 / 64), kb = r / (1024 / 64);
        c.src = p->w_ukv + (size_t)l * 256 * 1024 + nb * 64 + n4; c.ldw = 1024; c.gain = p->kv_norm + l * 256; c.dst = (bf16_t*)(lw + LW_UKV); c.K = 256; c.n0 = nb * 64; c.k0 = kb * 256;
    } else {
        r -= C4; const int nb = r % (D / 64), kb = r / (D / 64);
        c.src = p->w_out + (size_t)l * D * D + nb * 64 + n4; c.ldw = D; c.dst = (bf16_t*)(lw + LW_WO); c.K = D; c.n0 = nb * 64; c.k0 = kb * 256;
    }
}
constexpr int CVT_ITEMS = 2 * (2 * ((NGU / 64) * (D / 256)) + 2 * ((D / 64) * (DFF / 256)) + (NIN / 64) * (D / 256) + (768 / 64) * 2 + (1024 / 64) + (D / 64) * (D / 256));

#define CVT_LOAD(S, c_) do { _Pragma("unroll") for (int i = 0; i < 8; ++i) v##S[i] = (c_).src ? __builtin_nontemporal_load((const f32x4*)((c_).src + (size_t)((c_).k0 + kq + 32 * i) * (c_).ldw)) : (f32x4){0.f, 0.f, 0.f, 0.f}; } while (0)
#define CVT_EMIT(S, c_) do { \
        _Pragma("unroll") for (int i = 0; i < 8; ++i) { const int kl = kq + 32 * i; const float g = (c_).gain ? (c_).gain[(c_).k0 + kl] : 1.f; \
            float* tp = tile + kl * 65 + n4; tp[0] = v##S[i][0] * g; tp[1] = v##S[i][1] * g; tp[2] = v##S[i][2] * g; tp[3] = v##S[i][3] * g; } \
        __syncthreads(); \
        bf16_t* dst = (c_).dst; const int K = (c_).K, n0 = (c_).n0, k0 = (c_).k0; \
        if (itn < hi) { cvt_decode(p, itn, n4, (c_)); CVT_LOAD(S, c_); } \
        { const int kc_lo = t & 7, nl = t >> 3; \
          _Pragma("unroll") for (int i = 0; i < 4; ++i) { const int k8 = (kc_lo + 8 * i) * 8; float w[8]; \
            _Pragma("unroll") for (int j = 0; j < 8; ++j) w[j] = tile[(k8 + j) * 65 + nl]; \
            u32x4 o; o.x = cvt_pk_bf16(w[0], w[1]); o.y = cvt_pk_bf16(w[2], w[3]); o.z = cvt_pk_bf16(w[4], w[5]); o.w = cvt_pk_bf16(w[6], w[7]); \
            *(u32x4*)(dst + (size_t)(n0 + nl) * K + k0 + k8) = o; } } \
        __syncthreads(); } while (0)
__device__ __forceinline__ void cvt_range(PP p, float* tile, const int tid_, const int lo, const int hi, const int first, const int stride) {
    const int t = tid_, n4 = (t & 15) * 4, kq = t >> 4;
    f32x4 vA[8], vB[8];
    CvtItem cA, cB;
    int it = lo + first;
    if (it < hi) { cvt_decode(p, it, n4, cA); CVT_LOAD(A, cA); }
    if (it + stride < hi) { cvt_decode(p, it + stride, n4, cB); CVT_LOAD(B, cB); }
#pragma unroll 1
    for (; it < hi; it += 2 * stride) {
        { const int itn = it + 2 * stride; CVT_EMIT(A, cA); }
        if (it + stride < hi) { const int itn = it + 3 * stride; CVT_EMIT(B, cB); }
    }
}
#undef CVT_LOAD
#undef CVT_EMIT
__shared__ uint4 ctl_words;
constexpr int CVT_CH = 2;
__device__ __forceinline__ void cvt_dyn(PP p, float* tile, const int tid_, const int lo, const int hi, unsigned* ctr) {
    volatile XLAS unsigned* s_chunk_p = (volatile XLAS unsigned*)&ctl_words + 3;
    for (;;) {
        if (tid_ == 0) *s_chunk_p = atomicAdd(ctr, (unsigned)CVT_CH);
        __syncthreads();
        const int base = lo + (int)*s_chunk_p;
        __syncthreads();
        if (base >= hi) break;
        cvt_range(p, tile, tid_, base, base + CVT_CH < hi ? base + CVT_CH : hi, 0, 1);
    }
}

constexpr int NCONV = 16;
constexpr int CV_L = CVT_ITEMS / 2;
constexpr int CV_CG = 2400, CV_CA = 1400;
constexpr int cv_max(int a, int b) { return a > b ? a : b; }
constexpr int CV_E15 = CVT_ITEMS;
constexpr int CV_E13 = CVT_ITEMS - (D / 64) * (DFF / 256);
constexpr int CV_D_UQKV1 = CV_L + 2664, CV_D_GU1_1 = CV_L + 1408, CV_D_GU2_0 = 4328, CV_D_UQKV0 = 2664;
constexpr int CV_E9 = cv_max(CV_D_UQKV1, CV_E13 - CV_CA);
constexpr int CV_E7 = cv_max(CV_D_GU1_1, CV_E9 - CV_CG);
constexpr int CV_E5 = cv_max(CV_D_GU2_0, CV_E7 - CV_CG);
constexpr int CV_E1 = cv_max(CV_D_UQKV0, CV_E5 - CV_CA);
constexpr int CV_P0 = cv_max(1408, CV_E1 - CV_CG);
static_assert(CV_L == 5032 && CV_E13 - CV_E9 >= 0 && CV_E15 - CV_E13 == 704, "conversion schedule");

__device__ __forceinline__ void prep_phase(PP p, float* tile, const int tid_) {
    const int wid = tid_ >> 6, lane = tid_ & 63;
    float* ss = (float*)(p->ws + OFF_SS);
    bf16_t* xb = (bf16_t*)(p->ws + OFF_XB);
    for (int row = blockIdx.x * 8 + wid; row < T; row += gridDim.x * 8) {
        float s = 0.f;
#pragma unroll
        for (int i = 0; i < 8; ++i) {
            const size_t o = (size_t)row * D + i * 256 + lane * 4;
            const f32x4 v = *(const f32x4*)(p->x + o);
            s += v[0] * v[0] + v[1] * v[1] + v[2] * v[2] + v[3] * v[3];
            u32x2 w; w.x = cvt_pk_bf16(v[0], v[1]); w.y = cvt_pk_bf16(v[2], v[3]);
            *(u32x2*)(xb + o) = w;
        }
#pragma unroll
        for (int o = 1; o < 64; o <<= 1) s += __shfl_xor(s, o);
        if (lane == 0) ss[row] = s;
    }
    for (int i = blockIdx.x * NTHREADS + tid_; i < 10 * T; i += gridDim.x * NTHREADS) ss[T + i] = 0.f;
    float* r128 = (float*)(p->ws + OFF_R128); float* r64 = (float*)(p->ws + OFF_R64);
    for (int i = blockIdx.x * NTHREADS + tid_; i < SEQ * 64; i += gridDim.x * NTHREADS) {
        const int pos = i >> 6, f = i & 63;
        const float inv = 1.0f / powf(10000.0f, (float)f * (2.0f / 128.0f));
        const float ang = (float)pos * inv;
        float cs, sn; sincos_rr(ang, cs, sn);
        r128[2 * i] = cs; r128[2 * i + 1] = sn;
    }
    for (int i = blockIdx.x * NTHREADS + tid_; i < SEQ * 32; i += gridDim.x * NTHREADS) {
        const int pos = i >> 5, f = i & 31;
        const float inv = 1.0f / powf(10000.0f, (float)f * (2.0f / 64.0f));
        const float ang = (float)pos * inv;
        float cs, sn; sincos_rr(ang, cs, sn);
        r64[2 * i] = cs; r64[2 * i + 1] = sn;
    }
}

__device__ __forceinline__ void post_phase(PP p, int layer, float* red, const int tid_) {
    const float* z = (const float*)(p->ws + OFF_U);
    const float* r128 = (const float*)(p->ws + OFF_R128); const float* r64 = (const float*)(p->ws + OFF_R64);
    bf16_t* cqn = (bf16_t*)(p->ws + OFF_CQN); bf16_t* ckvn = (bf16_t*)(p->ws + OFF_CKVN); bf16_t* kpe = (bf16_t*)(p->ws + OFF_KPE);
    bf16_t* mq = (bf16_t*)(p->ws + OFF_MQ); bf16_t* mk = (bf16_t*)(p->ws + OFF_MK); bf16_t* mv = (bf16_t*)(p->ws + OFF_MV);
    bf16_t* sq = (bf16_t*)(p->ws + OFF_SQ); bf16_t* sk = (bf16_t*)(p->ws + OFF_SK); bf16_t* sv = (bf16_t*)(p->ws + OFF_SV);
    bf16_t* kbar = (bf16_t*)(p->ws + OFF_KBAR);
    const int wid = tid_ >> 6, lane = tid_ & 63;
    constexpr int NU = 27;
    for (int it = blockIdx.x; it < 32 * NU; it += gridDim.x) {
        const int tb = it / NU, u = it % NU;
        const int row0 = tb * 256 + wid * 32;
        if (u == 0) {
            const float* g = p->q_norm + layer * 512;
            const f32x4 g0 = *(const f32x4*)(g + lane * 4), g1 = *(const f32x4*)(g + 256 + lane * 4);
            for (int rr = 0; rr < 32; ++rr) {
                const int row = row0 + rr; const float* zr = z + (size_t)row * NIN;
                const f32x4 a = *(const f32x4*)(zr + lane * 4), b = *(const f32x4*)(zr + 256 + lane * 4);
                float s = a[0] * a[0] + a[1] * a[1] + a[2] * a[2] + a[3] * a[3] + b[0] * b[0] + b[1] * b[1] + b[2] * b[2] + b[3] * b[3];
#pragma unroll
                for (int o = 1; o < 64; o <<= 1) s += __shfl_xor(s, o);
                const float r = rsqrtf(s * (1.0f / 512.0f) + EPS);
                u32x2 w0, w1;
                w0.x = cvt_pk_bf16(a[0] * r * g0[0], a[1] * r * g0[1]); w0.y = cvt_pk_bf16(a[2] * r * g0[2], a[3] * r * g0[3]);
                w1.x = cvt_pk_bf16(b[0] * r * g1[0], b[1] * r * g1[1]); w1.y = cvt_pk_bf16(b[2] * r * g1[2], b[3] * r * g1[3]);
                *(u32x2*)(cqn + (size_t)row * 512 + lane * 4) = w0; *(u32x2*)(cqn + (size_t)row * 512 + 256 + lane * 4) = w1;
            }
        } else if (u == 1) {
            const f32x4 g0 = *(const f32x4*)(p->kv_norm + layer * 256 + lane * 4);
            for (int rr = 0; rr < 32; ++rr) {
                const int row = row0 + rr; const float* zr = z + (size_t)row * NIN + 512;
                const f32x4 a = *(const f32x4*)(zr + lane * 4);
                float s = a[0] * a[0] + a[1] * a[1] + a[2] * a[2] + a[3] * a[3];
#pragma unroll
                for (int o = 1; o < 64; o <<= 1) s += __shfl_xor(s, o);
                const float r = rsqrtf(s * (1.0f / 256.0f) + EPS);
                u32x2 w0; w0.x = cvt_pk_bf16(a[0] * r * g0[0], a[1] * r * g0[1]); w0.y = cvt_pk_bf16(a[2] * r * g0[2], a[3] * r * g0[3]);
                *(u32x2*)(ckvn + (size_t)row * 256 + lane * 4) = w0;
            }
        } else if (u == 2) {
            for (int rr = 0; rr < 32; ++rr) {
                const int row = row0 + rr, pos = row & (SEQ - 1); const float* zr = z + (size_t)row * NIN + 768;
                const int f = lane & 31;
                const float x1 = zr[f], x2 = zr[f + 32];
                const float c = r64[(pos * 32 + f) * 2], s = r64[(pos * 32 + f) * 2 + 1];
                const float o = (lane < 32) ? (x1 * c - x2 * s) : (x2 * c + x1 * s);
                kpe[(size_t)row * 64 + lane] = cvt_bf16(o);
            }
        } else {
            int zc; bf16_t* dst; int ld; int dc; bool rope = true; bool isk = false; int hk = 0;
            if (u < 7) { const int h = u - 3; zc = 832 + h * 128; dst = mq; ld = 512; dc = h * 128; }
            else if (u < 11) { const int h = u - 7; zc = 1344 + h * 128; dst = mk; ld = 512; dc = h * 128; isk = true; hk = h; }
            else if (u < 15) { const int h = u - 11; zc = 1856 + h * 128; dst = mv; ld = 512; dc = h * 128; rope = false; }
            else if (u < 23) { const int h = u - 15; zc = 2368 + h * 128; dst = sq; ld = 1024; dc = h * 128; }
            else if (u < 25) { const int h = u - 23; zc = 3392 + h * 128; dst = sk; ld = 256; dc = h * 128; }
            else { const int h = u - 25; zc = 3648 + h * 128; dst = sv; ld = 256; dc = h * 128; rope = false; }
            float a1 = 0.f, a2 = 0.f;
            for (int rr = 0; rr < 32; ++rr) {
                const int row = row0 + rr, pos = row & (SEQ - 1); const float* zr = z + (size_t)row * NIN + zc;
                const float x1 = zr[lane], x2 = zr[lane + 64];
                float o1 = x1, o2 = x2;
                if (rope) {
                    const float c = r128[(pos * 64 + lane) * 2], s = r128[(pos * 64 + lane) * 2 + 1];
                    o1 = x1 * c - x2 * s; o2 = x2 * c + x1 * s;
                }
                a1 += o1; a2 += o2;
                dst[(size_t)row * ld + dc + lane] = cvt_bf16(o1); dst[(size_t)row * ld + dc + 64 + lane] = cvt_bf16(o2);
            }
            if (isk) {
                red[wid * 128 + lane] = a1; red[wid * 128 + 64 + lane] = a2;
                __syncthreads();
                if (tid_ < 128) {
                    float s = 0.f;
#pragma unroll
                    for (int w = 0; w < 8; ++w) s += red[w * 128 + tid_];
                    const int b = tb >> 4, n = tb & 15;
                    kbar[((size_t)(b * 4 + hk) * 16 + n) * 128 + tid_] = cvt_bf16(s * (1.0f / 256.0f));
                }
                __syncthreads();
            }
        }
    }
}

template <int DQ, int TYPE>
__device__ __forceinline__ void attn_item(PP p, int layer, int b, int h, int qt, char* lds, const int tid_, unsigned* next_ctr, volatile XLAS unsigned* slot) {
    constexpr int KLD = DQ + 8, NKS = DQ / 16, KBYTES = 64 * KLD * 2, VLD = 68, STAGE = KBYTES + 128 * VLD * 2;
    const int t = tid_, wid = __builtin_amdgcn_readfirstlane(t >> 6), lane = t & 63, r = lane & 31, hh = lane >> 5, qg = wid & 3, kh = wid >> 2;
    const size_t tok0 = (size_t)b * SEQ;
    const bf16_t *Qp, *Kp, *Vp, *Kpe = nullptr; int ldq, ldk, ldv; bf16_t* Op; float scale;
    if (TYPE == 0) {
        Qp = (const bf16_t*)(p->ws + OFF_QB) + tok0 * 768 + h * 192; ldq = 768;
        Kp = (const bf16_t*)(p->ws + OFF_KVB) + tok0 * 1024 + h * 256; ldk = 1024;
        Vp = Kp + 128; ldv = 1024;
        Kpe = (const bf16_t*)(p->ws + OFF_KPE) + tok0 * 64;
        Op = (bf16_t*)(p->ws + OFF_OB) + tok0 * D + h * 128; scale = 0.07216878364870322f;
    } else if (TYPE == 1) {
        Qp = (const bf16_t*)(p->ws + OFF_MQ) + tok0 * 512 + h * 128; ldq = 512;
        Kp = (const bf16_t*)(p->ws + OFF_MK) + tok0 * 512 + h * 128; ldk = 512;
        Vp = (const bf16_t*)(p->ws + OFF_MV) + tok0 * 512 + h * 128; ldv = 512;
        Op = (bf16_t*)(p->ws + OFF_OB) + tok0 * D + 512 + h * 128; scale = 0.08838834764831845f;
    } else {
        Qp = (const bf16_t*)(p->ws + OFF_SQ) + tok0 * 1024 + h * 128; ldq = 1024;
        Kp = (const bf16_t*)(p->ws + OFF_SK) + tok0 * 256 + (h >> 2) * 128; ldk = 256;
        Vp = (const bf16_t*)(p->ws + OFF_SV) + tok0 * 256 + (h >> 2) * 128; ldv = 256;
        Op = (bf16_t*)(p->ws + OFF_OB) + tok0 * D + 1024 + h * 128; scale = 0.08838834764831845f;
    }
    const float c = scale * LOG2E;
    const int j_hi = 2 * qt + 1, j_lo = (TYPE == 2) ? (qt > 0 ? 2 * qt - 2 : 0) : 0;
    const int own = qt >> 1;
    const int qpos = 128 * qt + 32 * qg + r;

    u32x4 kregA[DQ == 192 ? 3 : 2], vregA[2];
    const int dg = t & 15, kp = t >> 4;
#define A_GLOAD(S, j_) do { const size_t k0_ = (size_t)(j_) * 64; \
        _Pragma("unroll") for (int i = 0; i < 2; ++i) { const int id = t + 512 * i, row = id >> 4, ch = id & 15; kreg##S[i] = *(const u32x4*)(Kp + (k0_ + row) * ldk + ch * 8); } \
        if (TYPE == 0) { const int row = t >> 3, ch = t & 7; kreg##S[DQ == 192 ? 2 : 0] = *(const u32x4*)(Kpe + (k0_ + row) * 64 + ch * 8); } \
        _Pragma("unroll") for (int i = 0; i < 2; ++i) vreg##S[i] = *(const u32x4*)(Vp + (k0_ + 2 * kp + i) * ldv + dg * 8); } while (0)
#define A_LSTORE(S, buf_) do { bf16_t* Ks_ = (bf16_t*)(lds + (buf_) * STAGE); bf16_t* Vt_ = (bf16_t*)(lds + (buf_) * STAGE + KBYTES); \
        _Pragma("unroll") for (int i = 0; i < 2; ++i) { const int id = t + 512 * i, row = id >> 4, ch = id & 15; *(u32x4*)(Ks_ + row * KLD + ch * 8) = kreg##S[i]; } \
        if (TYPE == 0) { const int row = t >> 3, ch = t & 7; *(u32x4*)(Ks_ + row * KLD + 128 + ch * 8) = kreg##S[DQ == 192 ? 2 : 0]; } \
        _Pragma("unroll") for (int w = 0; w < 4; ++w) { const unsigned a0 = vreg##S[0][w], a1 = vreg##S[1][w]; \
            *(unsigned*)(Vt_ + (dg * 8 + 2 * w) * VLD + 2 * kp) = (a0 & 0xffffu) | (a1 << 16); \
            *(unsigned*)(Vt_ + (dg * 8 + 2 * w + 1) * VLD + 2 * kp) = (a0 >> 16) | (a1 & 0xffff0000u); } } while (0)

    A_GLOAD(A, j_lo);
    bf16x8 qf[NKS];
    {
        const bf16_t* qrow = Qp + (size_t)qpos * ldq + 8 * hh;
#pragma unroll
        for (int ks = 0; ks < NKS; ++ks) qf[ks] = *(const bf16x8*)(qrow + 16 * ks);
        if (TYPE == 0) {
            const float* r64 = (const float*)(p->ws + OFF_R64) + (size_t)qpos * 64;
#pragma unroll
            for (int kk = 0; kk < 2; ++kk) {
                bf16x8 x1 = qf[8 + kk], x2 = qf[10 + kk], o1, o2;
#pragma unroll
                for (int j = 0; j < 8; ++j) {
                    const int f = 16 * kk + 8 * hh + j;
                    const float cs = r64[2 * f], sn = r64[2 * f + 1];
                    const float a = __uint_as_float(((unsigned)(unsigned short)x1[j]) << 16), bb = __uint_as_float(((unsigned)(unsigned short)x2[j]) << 16);
                    o1[j] = (short)cvt_bf16(a * cs - bb * sn); o2[j] = (short)cvt_bf16(bb * cs + a * sn);
                }
                qf[8 + kk] = o1; qf[10 + kk] = o2;
            }
        }
    }
    unsigned qmask = 0;
    if (TYPE == 1) {
        if (own > 0) {
            const float* kb = (const float*)(p->ws + OFF_KBARF) + (size_t)layer * 16384 + (size_t)(b * 4 + h) * 16 * 128;
            f32x16 g = {};
#pragma unroll
            for (int ks = 0; ks < 8; ++ks) {
                bf16x8 a = {};
                if (r < 16) {
                    const f32x4 k0v = *(const f32x4*)(kb + r * 128 + 16 * ks + 8 * hh), k1v = *(const f32x4*)(kb + r * 128 + 16 * ks + 8 * hh + 4);
                    u32x4 pk; pk.x = cvt_pk_bf16(k0v[0] * (1.0f / 256.0f), k0v[1] * (1.0f / 256.0f)); pk.y = cvt_pk_bf16(k0v[2] * (1.0f / 256.0f), k0v[3] * (1.0f / 256.0f));
                    pk.z = cvt_pk_bf16(k1v[0] * (1.0f / 256.0f), k1v[1] * (1.0f / 256.0f)); pk.w = cvt_pk_bf16(k1v[2] * (1.0f / 256.0f), k1v[3] * (1.0f / 256.0f));
                    a = __builtin_bit_cast(bf16x8, pk);
                }
                g = __builtin_amdgcn_mfma_f32_32x32x16_bf16(a, qf[ks], g, 0, 0, 0);
            }
            float mine[8], theirs[8];
#pragma unroll
            for (int i = 0; i < 8; ++i) { mine[i] = g[i]; theirs[i] = __shfl_xor(g[i], 32); }
            unsigned bits = 0;
#pragma unroll
            for (int i = 0; i < 8; ++i) {
                const int n = 8 * (i >> 2) + 4 * hh + (i & 3);
                int rank = 0;
#pragma unroll
                for (int i2 = 0; i2 < 8; ++i2) {
                    const int n1 = 8 * (i2 >> 2) + 4 * hh + (i2 & 3), n2 = 8 * (i2 >> 2) + 4 * (1 - hh) + (i2 & 3);
                    if (n1 < own && (mine[i2] > mine[i] || (mine[i2] == mine[i] && n1 < n))) ++rank;
                    if (n2 < own && (theirs[i2] > mine[i] || (theirs[i2] == mine[i] && n2 < n))) ++rank;
                }
                if (n < own && rank < 3) bits |= 1u << n;
            }
            qmask = bits | (unsigned)__shfl_xor((int)bits, 32);
        }
    }

    f32x16 O[4];
#pragma unroll
    for (int md = 0; md < 4; ++md)
#pragma unroll
        for (int i = 0; i < 16; ++i) O[md][i] = 0.f;
    float m_run = -1e30f, l_run = 0.f;
    if (TYPE == 2 && kh == 0) { m_run = p->sinks[layer * 8 + h] * LOG2E; l_run = (hh == 0) ? 1.f : 0.f; }
    constexpr int GK = (DQ == 192) ? 3 : 4, NG = NKS / GK;

    A_LSTORE(A, 0); __syncthreads();
    if (kh == 0) __builtin_amdgcn_s_setprio(2);
#pragma unroll 1
    for (int j = j_lo; j <= j_hi; ++j) {
        const int buf = (j - j_lo) & 1;
        if (j < j_hi) A_GLOAD(A, j + 1);
        int mode = 0;
        if (TYPE == 2) mode = 2;
        else if (TYPE == 1 && (j >> 2) < own) mode = 3;
        else if (j >= 2 * qt) mode = 1;
        const int kbase_pos = 64 * j + 32 * kh;
        const int qlo = 128 * qt + 32 * qg;
        bool skip = false;
        if (mode == 1 || mode == 2) { if (kbase_pos > qlo + 31) skip = true; }
        if (mode == 2) { if (kbase_pos + 31 <= qlo - 128) skip = true; }
        if (!skip) {
            const bf16_t* Ks = (const bf16_t*)(lds + buf * STAGE); const bf16_t* Vt = (const bf16_t*)(lds + buf * STAGE + KBYTES);
            f32x16 sacc;
#pragma unroll
            for (int i = 0; i < 16; ++i) sacc[i] = 0.f;
            const bf16_t* kb_ = Ks + (32 * kh + r) * KLD + 8 * hh;
            bf16x8 kf[2][GK];
#pragma unroll
            for (int i = 0; i < GK; ++i) kf[0][i] = *(const bf16x8*)(kb_ + 16 * i);
#pragma unroll
            for (int g = 0; g < NG; ++g) {
                if (g + 1 < NG) {
#pragma unroll
                    for (int i = 0; i < GK; ++i) kf[(g + 1) & 1][i] = *(const bf16x8*)(kb_ + 16 * ((g + 1) * GK + i));
                }
                __builtin_amdgcn_sched_barrier(0);
#pragma unroll
                for (int i = 0; i < GK; ++i) sacc = __builtin_amdgcn_mfma_f32_32x32x16_bf16(kf[g & 1][i], qf[g * GK + i], sacc, 0, 0, 0);
                __builtin_amdgcn_sched_barrier(0);
            }
            const bf16_t* vb0 = Vt + r * VLD + 32 * kh + 4 * hh;
            u32x2 vf[2][4][2];
#pragma unroll
            for (int md = 0; md < 4; ++md) { vf[0][md][0] = *(const u32x2*)(vb0 + md * 32 * VLD); vf[0][md][1] = *(const u32x2*)(vb0 + md * 32 * VLD + 8); }
            if (mode != 0) {
                const bool selbit = (qmask >> (j >> 2)) & 1u;
#pragma unroll
                for (int i = 0; i < 16; ++i) {
                    const int kpos = kbase_pos + 8 * (i >> 2) + 4 * hh + (i & 3);
                    const int dd = qpos - kpos;
                    bool ok;
                    if (mode == 1) ok = dd >= 0; else if (mode == 2) ok = (dd >= 0 && dd < 128); else ok = selbit;
                    if (!ok) sacc[i] = -INFINITY;
                }
            }
            float mx = fmaxf(sacc[0], sacc[1]);
#pragma unroll
            for (int i = 2; i < 16; i += 2) mx = fmaxf(mx, fmaxf(sacc[i], sacc[i + 1]));
            mx *= c;
            mx = fmaxf(mx, __shfl_xor(mx, 32));
            const float m_old_ = m_run;
            const float mnew = fmaxf(m_run, mx);
            const float alpha = fast_exp2(m_run - mnew);
            m_run = mnew;
            float ls = 0.f;
#pragma unroll
            for (int i = 0; i < 16; ++i) { sacc[i] = fast_exp2(__builtin_fmaf(sacc[i], c, -mnew)); ls += sacc[i]; }
            l_run = l_run * alpha + ls;
            if (__builtin_amdgcn_ballot_w64(mx > m_old_) != 0) {
#pragma unroll
                for (int md = 0; md < 4; ++md) O[md] *= alpha;
            }
#pragma unroll
            for (int s2 = 0; s2 < 2; ++s2) {
                if (s2 == 0) {
#pragma unroll
                    for (int md = 0; md < 4; ++md) { vf[1][md][0] = *(const u32x2*)(vb0 + 16 + md * 32 * VLD); vf[1][md][1] = *(const u32x2*)(vb0 + 16 + md * 32 * VLD + 8); }
                }
                u32x4 pb;
                pb.x = cvt_pk_bf16(sacc[8 * s2 + 0], sacc[8 * s2 + 1]); pb.y = cvt_pk_bf16(sacc[8 * s2 + 2], sacc[8 * s2 + 3]);
                pb.z = cvt_pk_bf16(sacc[8 * s2 + 4], sacc[8 * s2 + 5]); pb.w = cvt_pk_bf16(sacc[8 * s2 + 6], sacc[8 * s2 + 7]);
                const bf16x8 bfrag = __builtin_bit_cast(bf16x8, pb);
                __builtin_amdgcn_sched_barrier(0);
#pragma unroll
                for (int md = 0; md < 4; ++md) {
                    u32x4 av; av.x = vf[s2][md][0].x; av.y = vf[s2][md][0].y; av.z = vf[s2][md][1].x; av.w = vf[s2][md][1].y;
                    O[md] = __builtin_amdgcn_mfma_f32_32x32x16_bf16(__builtin_bit_cast(bf16x8, av), bfrag, O[md], 0, 0, 0);
                }
                __builtin_amdgcn_sched_barrier(0);
            }
        }
        if (j < j_hi) A_LSTORE(A, buf ^ 1);
        __syncthreads();
    }
#undef A_GLOAD
#undef A_LSTORE
    __builtin_amdgcn_s_setprio(0);
    unsigned nxt_item = 0; if (tid_ == 0) nxt_item = atomicAdd(next_ctr, 1u);
    l_run += __shfl_xor(l_run, 32);
    float* mrg = (float*)lds;
    {
        float* mp = mrg + (size_t)((qg * 2 + kh) * 34) * 64 + lane;
        if (kh == 0) {
#pragma unroll
            for (int t2 = 0; t2 < 2; ++t2)
#pragma unroll
                for (int i = 0; i < 16; ++i) mp[(t2 * 16 + i) * 64] = O[2 + t2][i];
        } else {
#pragma unroll
            for (int t2 = 0; t2 < 2; ++t2)
#pragma unroll
                for (int i = 0; i < 16; ++i) mp[(t2 * 16 + i) * 64] = O[t2][i];
        }
        mp[32 * 64] = m_run; mp[33 * 64] = l_run;
    }
    __syncthreads();
    {
        const float* mp = mrg + (size_t)((qg * 2 + (kh ^ 1)) * 34) * 64 + lane;
        const float m1 = mp[32 * 64], l1 = mp[33 * 64];
        const float mt = fmaxf(m_run, m1);
        const float a0 = fast_exp2(m_run - mt), a1 = fast_exp2(m1 - mt);
        const float inv = 1.0f / (l_run * a0 + l1 * a1);
        bf16_t* orow = Op + (size_t)qpos * D;
#define A_MERGE(MD0) do { _Pragma("unroll") for (int t2 = 0; t2 < 2; ++t2) _Pragma("unroll") for (int g4 = 0; g4 < 4; ++g4) { float v[4]; \
            _Pragma("unroll") for (int j = 0; j < 4; ++j) v[j] = (O[(MD0) + t2][g4 * 4 + j] * a0 + mp[(t2 * 16 + g4 * 4 + j) * 64] * a1) * inv; \
            u32x2 w; w.x = cvt_pk_bf16(v[0], v[1]); w.y = cvt_pk_bf16(v[2], v[3]); \
            *(u32x2*)(orow + 32 * ((MD0) + t2) + 8 * g4 + 4 * hh) = w; } } while (0)
        if (kh == 0) A_MERGE(0); else A_MERGE(2);
#undef A_MERGE
    }
    if (tid_ == 0) *slot = nxt_item;
    __syncthreads();
}

__device__ __forceinline__ void attn_phase(PP p, int layer, char* lds, const int tid_) {
    unsigned* cnt = (unsigned*)(p->ws + OFF_CNT) + layer * 8;
    volatile XLAS unsigned* s_item_p = (volatile XLAS unsigned*)&ctl_words + 2;
    const int x0 = (int)(xb_xcc_id() & 7u);
    int k = 0;
    bool have = false;
    for (;;) {
        const int x = (x0 + k) & 7;
        if (!have) {
            if (tid_ == 0) *s_item_p = atomicAdd(cnt + x, 1u);
            __syncthreads();
        }
        const int idx = (int)*s_item_p;
        __syncthreads();
        if (idx >= 128) { have = false; if (++k == 8) break; continue; }
        int tid_i = tid_; asm volatile("" : "+v"(tid_i));
        if (idx < 64) {
            static constexpr unsigned char kOrder[64] = {31, 30, 29, 28, 27, 26, 25, 63, 62, 24, 61, 23, 60, 22, 59, 21, 58, 57, 20, 56, 19, 55, 18, 54, 17, 53, 52, 16, 51, 15, 50, 14, 49, 13, 48, 47, 12, 46, 11, 45, 10, 44, 9, 43, 42, 8, 41, 7, 40, 6, 39, 5, 38, 37, 4, 36, 3, 35, 2, 34, 1, 33, 32, 0};
            const int e = kOrder[idx], qt = e & 31;
            if ((e >> 5) == 0) attn_item<192, 0>(p, layer, x >> 2, x & 3, qt, lds, tid_i, cnt + x, s_item_p);
            else attn_item<128, 1>(p, layer, x >> 2, x & 3, qt, lds, tid_i, cnt + x, s_item_p);
        } else {
            const int j = idx - 64, qt = 31 - (j >> 1), hs = 2 * x + (j & 1);
            attn_item<128, 2>(p, layer, hs >> 3, hs & 7, qt, lds, tid_i, cnt + x, s_item_p);
        }
        have = true;
    }
}

__device__ __forceinline__ void final_phase(PP p, const int tid_) {
    const float* x = (const float*)(p->ws + OFF_XRES); const float* ss = (const float*)(p->ws + OFF_SS) + 6 * T;
    const int wid = tid_ >> 6, lane = tid_ & 63;
    for (int row = blockIdx.x * 8 + wid; row < T; row += gridDim.x * 8) {
        const float r = rsqrtf(ss[row] * (1.0f / D) + EPS);
#pragma unroll
        for (int i = 0; i < 8; ++i) {
            const int cidx = i * 256 + lane * 4;
            const f32x4 v = *(const f32x4*)(x + (size_t)row * D + cidx), g = *(const f32x4*)(p->final_norm + cidx);
            *(f32x4*)(p->out + (size_t)row * D + cidx) = v * r * g;
        }
    }
}

extern __shared__ __attribute__((aligned(16))) char dyn_lds[];

__global__ void __launch_bounds__(NTHREADS) mega(Params p_arg) {
    cg::grid_group grid = cg::this_grid();
    if (threadIdx.x == 0) ctl_words = make_uint4(0u, 0u, 0u, 0u);
    __syncthreads();
    XcdBarrier xbar = xcd_barrier_post((unsigned*)(p_arg.ws + OFF_BAR), (volatile XLAS unsigned*)&ctl_words);
    if (p_arg.out == nullptr) grid.sync();
#pragma unroll 1
    for (int ph = ((DUP_MASK & 1) ? -1 : 0); ph < 18; ++ph) {
        PP p = (PP)__builtin_amdgcn_kernarg_segment_ptr();
        asm volatile("" : "+s"(p));
        int tid_ = threadIdx.x;
        asm volatile("" : "+v"(tid_));
        const int l = ph <= 0 ? 0 : (ph - 1) / 8, s = ph <= 0 ? -1 : (ph == 17 ? -2 : (ph - 1) % 8);
        const int ncv0 = (int)gridDim.x - NCONV;
        int cv_lo = 0, cv_hi = 0;
        if (s == -1) { cv_lo = 0; cv_hi = CV_P0; }
        else if (s == 0) { cv_lo = l == 0 ? CV_P0 : CV_E7; cv_hi = l == 0 ? CV_E1 : CV_E9; }
        else if (s == 4) { cv_lo = l == 0 ? CV_E1 : CV_E9; cv_hi = l == 0 ? CV_E5 : CV_E13; }
        else if (s == 6) { cv_lo = l == 0 ? CV_E5 : CV_E13; cv_hi = l == 0 ? CV_E7 : CV_E15; }
        const bool has_cv = (s == -1 || s == 0 || s == 4 || s == 6);
        const bool conv = (s == -1) || ((s == 0 || s == 4 || s == 6) && (int)blockIdx.x >= ncv0);
#pragma unroll 1
        for (int pass = 0; pass < 2; ++pass) {
        int tid_p = tid_; asm volatile("" : "+v"(tid_p));
        if (has_cv && ((pass == 0) == conv)) cvt_dyn(p, (float*)dyn_lds, tid_p, cv_lo, cv_hi, (unsigned*)(p->ws + OFF_CNT) + 33 + ph);
        if (pass == 1) break;
        if (ph <= 0) {
#ifndef NO_PREP
            prep_phase(p, (float*)dyn_lds, tid_);
#endif
        } else if (ph == 17) {
            final_phase(p, tid_);
        } else if (!conv) {
            if (s == 4) {
#ifndef NO_ATTN
                attn_phase(p, l, dyn_lds, tid_);
#endif
            } else {
                float* ss = (float*)(p->ws + OFF_SS);
                float* xres = (float*)(p->ws + OFF_XRES);
                bf16_t* xb = (bf16_t*)(p->ws + OFF_XB);
                bf16_t* act = (bf16_t*)(p->ws + OFF_U);
                const char* lw = p->ws + (size_t)l * LW_SIZE;
                GemmDesc d0{}, d1{};
                int n0 = 0, n1 = 0;
                if (s == 0 || s == 6) {
                    d0.A = xb; d0.Bt = (const bf16_t*)(lw + (s == 0 ? LW_GU1 : LW_GU2)); d0.nN = NGU / BM; d0.K = D; d0.epi = 0;
                    d0.ssin = ss + (3 * l + (s == 0 ? 0 : 2)) * T; d0.outb = act; n0 = 32 * (NGU / BM);
                } else if (s == 1 || s == 7) {
                    d0.A = act; d0.Bt = (const bf16_t*)(lw + (s == 1 ? LW_D1 : LW_D2)); d0.nN = D / BM; d0.K = DFF; d0.epi = 1;
                    d0.xin = (l == 0 && s == 1) ? p->x : xres; d0.outf = xres; d0.outb = xb; d0.ssout = ss + (3 * l + (s == 1 ? 1 : 3)) * T; d0.scale = 0.5f;
                    n0 = 32 * (D / BM);
                } else if (s == 2) {
                    d0.A = xb; d0.Bt = (const bf16_t*)(lw + LW_IN); d0.nN = NIN / BM; d0.K = D; d0.epi = 2;
                    d0.ssin = ss + (3 * l + 1) * T; d0.ws = p->ws; d0.layer = l; n0 = 32 * (NIN / BM);
                } else if (s == 3) {
                    d0.A = (const bf16_t*)(p->ws + OFF_CQN); d0.Bt = (const bf16_t*)(lw + LW_UQ); d0.nN = 3; d0.K = 512; d0.epi = 3;
                    d0.outb = (bf16_t*)(p->ws + OFF_QB); d0.ld = 768; d0.ssin = ss + (7 + 2 * l) * T; d0.scale = 1.0f / 512.0f; n0 = 96;
                    d1.A = (const bf16_t*)(p->ws + OFF_CKVN); d1.Bt = (const bf16_t*)(lw + LW_UKV); d1.nN = 4; d1.K = 256; d1.epi = 3;
                    d1.outb = (bf16_t*)(p->ws + OFF_KVB); d1.ld = 1024; d1.ssin = ss + (8 + 2 * l) * T; d1.scale = 1.0f / 256.0f; n1 = 128;
                } else {
                    d0.A = (const bf16_t*)(p->ws + OFF_OB); d0.Bt = (const bf16_t*)(lw + LW_WO); d0.nN = D / BM; d0.K = D; d0.epi = 1;
                    d0.xin = xres; d0.outf = xres; d0.outb = xb; d0.ssout = ss + (3 * l + 2) * T; d0.scale = 1.0f; n0 = 32 * (D / BM);
                }
#ifndef NO_GEMM
                const bool dup_ = (DUP_MASK & 2) && d0.epi == 0;
#pragma unroll 1
                for (int gi = 0; gi < ((n1 || dup_) ? 2 : 1); ++gi) {
                    const GemmDesc& d = (gi && !dup_) ? d1 : d0;
                    int tid_g = tid_; asm volatile("" : "+v"(tid_g));
                    const int Gg = d.epi == 0 ? ncv0 : (int)gridDim.x;
                    gemm_run((LAS unsigned char*)dyn_lds, d.A, d.Bt, 32, d.nN, d.K, Gg, (int)blockIdx.x - ((gi && !dup_) ? n0 : 0), EpiRt{d}, tid_);
                }
#endif
            }
        }
        }
        if (ph < 17) xcd_barrier(xbar);
        if ((DUP_MASK >> 9) & 1) xcd_barrier(xbar);
    }
}

extern "C" void kernel_launch(void* const* d_in, const int* in_sizes, int n_in, void* d_out, int out_size, void* d_ws, size_t ws_size,
                              hipStream_t stream) {
    constexpr size_t kDynLds = GEMM_LDS;
    static int grid_blocks = 0;
    if (!grid_blocks) {
        int dev = 0, cus = 0, per_cu = 0;
        (void)hipGetDevice(&dev);
        (void)hipDeviceGetAttribute(&cus, hipDeviceAttributeMultiprocessorCount, dev);
        (void)hipFuncSetAttribute((const void*)mega, hipFuncAttributeMaxDynamicSharedMemorySize, (int)kDynLds);
        (void)hipOccupancyMaxActiveBlocksPerMultiprocessor(&per_cu, mega, NTHREADS, kDynLds);
        if (per_cu < 1) per_cu = 1;
        grid_blocks = cus;
        if (ws_size < WS_NEED) fprintf(stderr, "workspace too small: %zu < %zu\n", ws_size, (size_t)WS_NEED);
    }
    Params p{};
    p.x = (const float*)d_in[0];
    p.ffn1_norm = (const float*)d_in[1]; p.ffn1_wg = (const float*)d_in[2]; p.ffn1_wu = (const float*)d_in[3]; p.ffn1_wd = (const float*)d_in[4];
    p.attn_norm = (const float*)d_in[5]; p.w_in = (const float*)d_in[6]; p.q_norm = (const float*)d_in[7]; p.w_uq = (const float*)d_in[8];
    p.kv_norm = (const float*)d_in[9]; p.w_ukv = (const float*)d_in[10]; p.sinks = (const float*)d_in[11]; p.w_out = (const float*)d_in[12];
    p.ffn2_norm = (const float*)d_in[13]; p.ffn2_wg = (const float*)d_in[14]; p.ffn2_wu = (const float*)d_in[15]; p.ffn2_wd = (const float*)d_in[16];
    p.final_norm = (const float*)d_in[17];
    p.out = (float*)d_out; p.ws = (char*)d_ws;
    (void)hipMemsetAsync((char*)d_ws + OFF_CNT, 0, CTL_BYTES, stream);
    void* args[] = {&p};
    hipError_t e = hipLaunchCooperativeKernel((const void*)mega, dim3(grid_blocks), dim3(NTHREADS), args, kDynLds, stream);
    if (e != hipSuccess) fprintf(stderr, "cooperative launch failed: %s (grid %d)\n", hipGetErrorString(e), grid_blocks);
}
```
